# Optimizing an MI355X kernel written in HIP

```python
import math
import jax, jax.numpy as jnp
from jax import lax
import numpy as np

D_MODEL = 1024
BATCH = 16
SEQ = 2048
DEPTH = 1

MIX_WIDTH = D_MODEL
RWKV_WIDTH = MIX_WIDTH // 2
RWKV_HEAD = 64
RWKV_HEADS = RWKV_WIDTH // RWKV_HEAD
DECAY_LORA = 64
ICL_LORA = 64
GATE_LORA = 128
GN_EPS = 64e-5
DIFF_WIDTH = MIX_WIDTH - RWKV_WIDTH
DIFF_HEAD = 64
DIFF_HEADS = DIFF_WIDTH // (2 * DIFF_HEAD)
DIFF_VDIM = 2 * DIFF_HEAD
Q_BLOCK = 128
RWKV_COLS = 3 * RWKV_WIDTH + DECAY_LORA + ICL_LORA + GATE_LORA
DIFF_COLS = 3 * DIFF_WIDTH
IN_COLS = RWKV_COLS + DIFF_COLS
N_EXPERTS = 32
TOP_K = 4
D_FF = D_MODEL
SWIGLU_ALPHA = 1.702
SWIGLU_LIMIT = 7.0
MOE_BLOCK = 128
NORM_EPS = 1e-5

kernel_name = 'hymba_rwkv7_diffattn_moe_layer'


def _rmsnorm(x, g, eps=NORM_EPS):
    xf = x.astype(jnp.float32)
    y = xf * lax.rsqrt(jnp.mean(xf * xf, axis=-1, keepdims=True) + eps)
    return (y * g.astype(jnp.float32)).astype(x.dtype)


def _alibi_slopes(n_heads):
    return 2.0 ** (-8.0 * (jnp.arange(n_heads, dtype=jnp.float32) + 1.0) / n_heads)


def _rwkv7_group(p, mu, w0, w_b, a0, a_b, g_b, k_k, k_a, r_k, ln_g, ln_b):
    bsz, seq, _ = p.shape
    f32 = jnp.float32
    prev = jnp.pad(p[:, :-1], ((0, 0), (1, 0), (0, 0)))
    p = p + (prev - p) * mu
    o1, o2, o3 = RWKV_WIDTH, 2 * RWKV_WIDTH, 3 * RWKV_WIDTH
    o4 = o3 + DECAY_LORA
    o5 = o4 + ICL_LORA
    r, k, v = p[..., :o1], p[..., o1:o2], p[..., o2:o3]
    w_lo, a_lo, g_lo = p[..., o3:o4], p[..., o4:o5], p[..., o5:]
    w = -jax.nn.softplus(-(w0 + jnp.tanh(w_lo) @ w_b).astype(f32)) - 0.5
    decay = jnp.exp(-jnp.exp(w))
    a = jax.nn.sigmoid(a0 + a_lo @ a_b)
    g = jax.nn.sigmoid(g_lo) @ g_b
    heads = lambda t: t.reshape(bsz, seq, RWKV_HEADS, RWKV_HEAD).astype(f32)
    kk = heads(k * k_k)
    kk = kk / jnp.maximum(jnp.sqrt(jnp.sum(kk * kk, axis=-1, keepdims=True)), 1e-12)
    k = k * (1.0 + (a - 1.0) * k_a)
    r_h, k_h, v_h, a_h, w_h = heads(r), heads(k), heads(v), heads(a), heads(decay)
    b_h = kk * a_h

    def step(state, inp):
        r_t, w_t, k_t, v_t, kk_t, b_t = inp
        sa = jnp.einsum('bhvk,bhk->bhv', state, kk_t)
        state = (state * w_t[:, :, None, :]
                 - sa[..., None] * b_t[:, :, None, :]
                 + v_t[..., None] * k_t[:, :, None, :])
        y_t = jnp.einsum('bhvk,bhk->bhv', state, r_t)
        return state, y_t

    xs = tuple(jnp.swapaxes(t, 0, 1) for t in (r_h, w_h, k_h, v_h, kk, b_h))
    state0 = jnp.zeros((bsz, RWKV_HEADS, RWKV_HEAD, RWKV_HEAD), f32)
    _, y = lax.scan(step, state0, xs)
    y = jnp.swapaxes(y, 0, 1)
    mean = jnp.mean(y, axis=-1, keepdims=True)
    var = jnp.mean(jnp.square(y - mean), axis=-1, keepdims=True)
    y = ((y - mean) * lax.rsqrt(var + GN_EPS)).reshape(bsz, seq, RWKV_WIDTH)
    y = y * ln_g.astype(f32) + ln_b.astype(f32)
    bonus = jnp.sum(r_h * k_h * r_k.astype(f32), axis=-1, keepdims=True) * v_h
    y = (y + bonus.reshape(bsz, seq, RWKV_WIDTH)) * g.astype(f32)
    return y.astype(p.dtype)


def _diff_attn_group(p, lq1, lk1, lq2, lk2, subln_g, lambda_init):
    bsz, seq, _ = p.shape
    f32 = jnp.float32
    q = p[..., :DIFF_WIDTH].reshape(bsz, seq, DIFF_HEADS, 2, DIFF_HEAD)
    k = p[..., DIFF_WIDTH:2 * DIFF_WIDTH].reshape(bsz, seq, DIFF_HEADS, 2, DIFF_HEAD)
    v = p[..., 2 * DIFF_WIDTH:].reshape(bsz, seq, DIFF_HEADS, DIFF_VDIM)
    lam = (jnp.exp(jnp.sum(lq1.astype(f32) * lk1.astype(f32)))
           - jnp.exp(jnp.sum(lq2.astype(f32) * lk2.astype(f32))) + lambda_init)
    slopes = _alibi_slopes(DIFF_HEADS)
    scale = DIFF_HEAD ** -0.5
    n_blocks = seq // Q_BLOCK
    q_blocks = jnp.swapaxes(q.reshape(bsz, n_blocks, Q_BLOCK, DIFF_HEADS, 2, DIFF_HEAD), 0, 1)
    k_pos = jnp.arange(seq)

    def block(args):
        q_blk, i = args
        s = jnp.einsum('bqhcd,bkhcd->bhcqk', q_blk, k).astype(f32) * scale
        q_pos = i * Q_BLOCK + jnp.arange(Q_BLOCK)
        dist = (q_pos[:, None] - k_pos[None, :]).astype(f32)
        s = s - slopes[None, :, None, None, None] * dist
        s = jnp.where(dist >= 0, s, -jnp.inf)
        pr = jax.nn.softmax(s, axis=-1)
        attn = pr[:, :, 0] - lam * pr[:, :, 1]
        return jnp.einsum('bhqk,bkhd->bqhd', attn.astype(v.dtype), v)

    o = lax.map(block, (q_blocks, jnp.arange(n_blocks)))
    o = jnp.swapaxes(o, 0, 1).reshape(bsz, seq, DIFF_HEADS, DIFF_VDIM)
    o = _rmsnorm(o, subln_g) * (1.0 - lambda_init)
    return o.reshape(bsz, seq, DIFF_WIDTH).astype(p.dtype)


def _moe(xn, router_w, router_b, w_up, b_up, w_down, b_down):
    bsz, seq, d = xn.shape
    xt = xn.reshape(-1, d)
    n_tok = xt.shape[0]
    logits = xt.astype(jnp.float32) @ router_w.astype(jnp.float32) + router_b.astype(jnp.float32)
    top_v, top_i = lax.top_k(logits, TOP_K)
    gate = jax.nn.softmax(top_v, axis=-1).astype(xt.dtype)
    n_assign = n_tok * TOP_K
    e_flat = top_i.reshape(n_assign)
    order = jnp.argsort(e_flat)
    e_sorted = e_flat[order]
    tok_sorted = (order // TOP_K).astype(jnp.int32)
    gate_sorted = gate.reshape(n_assign)[order]
    counts = jnp.bincount(e_flat, length=N_EXPERTS)
    start = jnp.cumsum(counts) - counts
    padded = (counts + MOE_BLOCK - 1) // MOE_BLOCK * MOE_BLOCK
    pad_end = jnp.cumsum(padded)
    pad_start = pad_end - padded
    dest = pad_start[e_sorted] + (jnp.arange(n_assign) - start[e_sorted])
    n_blocks = -(-n_assign // MOE_BLOCK) + N_EXPERTS
    n_slots = n_blocks * MOE_BLOCK
    slot_tok = jnp.zeros((n_slots,), jnp.int32).at[dest].set(tok_sorted)
    slot_gate = jnp.zeros((n_slots,), gate.dtype).at[dest].set(gate_sorted)
    blk_expert = jnp.minimum(
        jnp.searchsorted(pad_end, jnp.arange(n_blocks) * MOE_BLOCK, side='right'), N_EXPERTS - 1)

    def block(args):
        toks, gts, e = args
        h = xt[toks] @ w_up[e] + b_up[e]
        glu = jnp.minimum(h[:, ::2], SWIGLU_LIMIT)
        lin = jnp.clip(h[:, 1::2], -SWIGLU_LIMIT, SWIGLU_LIMIT)
        act = glu * jax.nn.sigmoid(SWIGLU_ALPHA * glu) * (lin + 1.0)
        y = act @ w_down[e] + b_down[e]
        return y * gts[:, None]

    ys = lax.map(block, (slot_tok.reshape(n_blocks, MOE_BLOCK),
                         slot_gate.reshape(n_blocks, MOE_BLOCK), blk_expert))
    out = jax.ops.segment_sum(ys.reshape(n_slots, d), slot_tok, num_segments=n_tok)
    return out.reshape(bsz, seq, d).astype(xn.dtype)


def setup_inputs(seed: int = 0) -> dict:
    key = jax.random.key(seed)
    ks = jax.random.split(key, 32)
    L, D, W = DEPTH, D_MODEL, RWKV_WIDTH
    nrm = lambda k, shape, s: jax.random.normal(k, shape, jnp.float32) * s
    return {
        'x': nrm(ks[0], (BATCH, SEQ, D), 1.0),
        'norm1_g': 1.0 + nrm(ks[1], (L, D), 0.05),
        'w_in': nrm(ks[2], (L, D, IN_COLS), D ** -0.5),
        'rwkv_mu': jax.random.uniform(ks[3], (L, RWKV_COLS), jnp.float32),
        'rwkv_w0': jax.random.uniform(ks[4], (L, W), jnp.float32, -6.0, 1.0),
        'rwkv_wb': nrm(ks[5], (L, DECAY_LORA, W), 0.5 * DECAY_LORA ** -0.5),
        'rwkv_a0': nrm(ks[6], (L, W), 0.1),
        'rwkv_ab': nrm(ks[7], (L, ICL_LORA, W), 0.5 * ICL_LORA ** -0.5),
        'rwkv_gb': nrm(ks[8], (L, GATE_LORA, W), GATE_LORA ** -0.5),
        'rwkv_kk': 0.85 + nrm(ks[9], (L, W), 0.05),
        'rwkv_ka': 1.0 + nrm(ks[10], (L, W), 0.05),
        'rwkv_rk': nrm(ks[11], (L, RWKV_HEADS, RWKV_HEAD), 0.1),
        'rwkv_ln_g': 1.0 + nrm(ks[12], (L, W), 0.05),
        'rwkv_ln_b': nrm(ks[13], (L, W), 0.01),
        'diff_lq1': nrm(ks[14], (L, DIFF_HEAD), 0.1),
        'diff_lk1': nrm(ks[15], (L, DIFF_HEAD), 0.1),
        'diff_lq2': nrm(ks[16], (L, DIFF_HEAD), 0.1),
        'diff_lk2': nrm(ks[17], (L, DIFF_HEAD), 0.1),
        'diff_subln_g': 1.0 + nrm(ks[18], (L, DIFF_VDIM), 0.05),
        'w_out': nrm(ks[19], (L, MIX_WIDTH, D), MIX_WIDTH ** -0.5),
        'norm2_g': 1.0 + nrm(ks[20], (L, D), 0.05),
        'router_w': nrm(ks[21], (L, D, N_EXPERTS), D ** -0.5),
        'router_b': nrm(ks[22], (L, N_EXPERTS), 0.01),
        'exp_w_up': nrm(ks[23], (L, N_EXPERTS, D, 2 * D_FF), D ** -0.5),
        'exp_b_up': nrm(ks[24], (L, N_EXPERTS, 2 * D_FF), 0.01),
        'exp_w_down': nrm(ks[25], (L, N_EXPERTS, D_FF, D), D_FF ** -0.5),
        'exp_b_down': nrm(ks[26], (L, N_EXPERTS, D), 0.01),
        'final_g': 1.0 + nrm(ks[27], (D,), 0.05),
    }


def reference(x, norm1_g, w_in, rwkv_mu, rwkv_w0, rwkv_wb, rwkv_a0, rwkv_ab, rwkv_gb,
              rwkv_kk, rwkv_ka, rwkv_rk, rwkv_ln_g, rwkv_ln_b, diff_lq1, diff_lk1,
              diff_lq2, diff_lk2, diff_subln_g, w_out, norm2_g, router_w, router_b,
              exp_w_up, exp_b_up, exp_w_down, exp_b_down, final_g):
    h = x
    for l in range(DEPTH):
        lambda_init = 0.8 - 0.6 * math.exp(-0.3 * l)
        xn = _rmsnorm(h, norm1_g[l])
        proj = xn @ w_in[l]
        y_rwkv = _rwkv7_group(proj[..., :RWKV_COLS], rwkv_mu[l], rwkv_w0[l], rwkv_wb[l],
                              rwkv_a0[l], rwkv_ab[l], rwkv_gb[l], rwkv_kk[l], rwkv_ka[l],
                              rwkv_rk[l], rwkv_ln_g[l], rwkv_ln_b[l])
        y_diff = _diff_attn_group(proj[..., RWKV_COLS:], diff_lq1[l], diff_lk1[l],
                                  diff_lq2[l], diff_lk2[l], diff_subln_g[l], lambda_init)
        h = h + jnp.concatenate([y_rwkv, y_diff], axis=-1) @ w_out[l]
        h = h + _moe(_rmsnorm(h, norm2_g[l]), router_w[l], router_b[l],
                     exp_w_up[l], exp_b_up[l], exp_w_down[l], exp_b_down[l])
    return _rmsnorm(h, final_g)
```

```cpp
#include <hip/hip_runtime.h>
#include <cstdint>
#include <cstdio>
#include <type_traits>

#define LAS __attribute__((address_space(3)))
typedef unsigned short bf16_t;
typedef float f32x4 __attribute__((ext_vector_type(4)));
typedef unsigned u32x2 __attribute__((ext_vector_type(2)));
typedef unsigned u32x4 __attribute__((ext_vector_type(4)));
typedef unsigned short u16x4 __attribute__((ext_vector_type(4)));

constexpr int NB = 16, SEQ = 2048, T = NB * SEQ, D = 1024;
constexpr int RW = 512, NRH = 8;
constexpr int NDH = 4;
constexpr int RCOLS = 1792, INC = 3328;
constexpr int NE = 32, TOPK = 4, DFF = 1024;
constexpr int NTHREADS = 512, NWAVES = 8;
constexpr int LDS_BYTES = 158720;
constexpr int MAXSLOT = T * TOPK + NE * 256;

constexpr size_t MiB = 1u << 20;
constexpr size_t WS_CTL = 0;
constexpr size_t CTL_BYTES = 1 * MiB;
constexpr size_t WS_LTOK = 1 * MiB, WS_LDST = 5 * MiB, WS_LGATE = 9 * MiB;
constexpr size_t WS_WIN = 16 * MiB, WS_WOUT = 24 * MiB, WS_WDN = 32 * MiB, WS_WUP = 96 * MiB;
constexpr size_t WS_WBT = 14 * MiB, WS_ABT = WS_WBT + 65536, WS_GBT = WS_ABT + 65536, WS_RWS = WS_WBT + 524288  ;
constexpr size_t WS_XN = 224 * MiB;
constexpr size_t WS_Y = 288 * MiB;
constexpr size_t WS_H1 = 352 * MiB;
constexpr size_t WS_PROJ = 480 * MiB;
constexpr size_t WS_REC = 688 * MiB;
constexpr size_t WS_RR = 688 * MiB, WS_RK = 720 * MiB, WS_RV = 752 * MiB, WS_RKK = 784 * MiB, WS_RB = 816 * MiB, WS_RG = 848 * MiB;
constexpr size_t WS_RW = 880 * MiB;
constexpr size_t WS_RKD = 944 * MiB;
constexpr size_t WS_OC = 945 * MiB;
constexpr size_t WS_ACT = 480 * MiB;
constexpr size_t WS_YK = 752 * MiB;
constexpr size_t WS_END = 1009 * MiB;

struct Args { const float* in[28]; float* out; unsigned char* ws; int ph_lo, ph_hi; };

__device__ __forceinline__ float bf2f(unsigned v) { return __uint_as_float(v << 16); }
__device__ __forceinline__ unsigned f2bf(float f) { unsigned u = __float_as_uint(f); return (u + 0x7fffu + ((u >> 16) & 1u)) >> 16; }
typedef float f32x2_t __attribute__((ext_vector_type(2))); typedef __bf16 bf16x2_t __attribute__((ext_vector_type(2)));
__device__ __forceinline__ unsigned pk2(float lo, float hi) { f32x2_t v = {lo, hi}; bf16x2_t b = __builtin_convertvector(v, bf16x2_t); return __builtin_bit_cast(unsigned, b); }
__device__ __forceinline__ float wave_sum(float v) {
#pragma unroll
    for (int o = 1; o < 64; o <<= 1) v += __shfl_xor(v, o);
    return v;
}
__device__ __forceinline__ float wave_max(float v) {
#pragma unroll
    for (int o = 1; o < 64; o <<= 1) v = fmaxf(v, __shfl_xor(v, o));
    return v;
}
template <int CTRL> __device__ __forceinline__ float dpp_f(float v) { return __int_as_float(__builtin_amdgcn_update_dpp(0, __float_as_int(v), CTRL, 0xF, 0xF, true)); }
typedef float f32x2 __attribute__((ext_vector_type(2)));
__device__ __forceinline__ float sigmoidf_(float x) { return 1.f / (1.f + __expf(-x)); }

__device__ __forceinline__ void rms_row(const float* xrow, const float* g, bf16_t* orow, int lane, float v_out[16]) {
    f32x4 v[4]; float ss = 0.f;
#pragma unroll
    for (int j = 0; j < 4; ++j) { v[j] = ((const f32x4*)xrow)[lane + 64 * j]; ss += v[j].x * v[j].x + v[j].y * v[j].y + v[j].z * v[j].z + v[j].w * v[j].w; }
    ss = wave_sum(ss);
    const float inv = rsqrtf(ss * (1.f / D) + 1e-5f);
#pragma unroll
    for (int j = 0; j < 4; ++j) {
        const f32x4 gg = ((const f32x4*)g)[lane + 64 * j];
        const f32x4 o = v[j] * inv * gg;
        v_out[4 * j + 0] = o.x; v_out[4 * j + 1] = o.y; v_out[4 * j + 2] = o.z; v_out[4 * j + 3] = o.w;
        if (orow) { u32x2 w; w.x = pk2(o.x, o.y); w.y = pk2(o.z, o.w); ((u32x2*)orow)[lane + 64 * j] = w; }
    }
}

#ifndef MFMA_GEMM
#define MFMA_GEMM 1
#endif
constexpr int NG_LD = 132;
template <class Epi>
__device__ __forceinline__ void ngemm_unit(LAS unsigned char* lds, const bf16_t* A, int lda, const float* W, int ldw, int n0, const Epi& epi) {
    LAS float* As = (LAS float*)lds; LAS float* Bs = As + 16 * NG_LD; LAS int* rowidx = (LAS int*)(Bs + 16 * NG_LD);
    const int tid = threadIdx.x, ty = tid >> 5, tx = tid & 31;
    float acc[8][4];
#pragma unroll
    for (int i = 0; i < 8; ++i)
#pragma unroll
        for (int j = 0; j < 4; ++j) acc[i][j] = 0.f;
    const int arow = tid >> 2, akq = (tid & 3) * 4;
    const int ridx = rowidx[arow]; const bf16_t* ap = A + (size_t)(ridx < 0 ? 0 : ridx) * lda + akq;
    const int bk = tid >> 5, bn = (tid & 31) * 4;
    const float* bp = W + (size_t)bk * ldw + n0 + bn;
    for (int k0 = 0; k0 < 1024; k0 += 16) {
        const u16x4 av = *(const u16x4*)(ap + k0);
        const f32x4 bv = *(const f32x4*)(bp + (size_t)k0 * ldw);
        __syncthreads();
        As[(akq + 0) * NG_LD + arow] = bf2f(av.x); As[(akq + 1) * NG_LD + arow] = bf2f(av.y); As[(akq + 2) * NG_LD + arow] = bf2f(av.z); As[(akq + 3) * NG_LD + arow] = bf2f(av.w);
        *(LAS f32x4*)(Bs + bk * NG_LD + bn) = bv;
        __syncthreads();
#pragma unroll 4
        for (int k = 0; k < 16; ++k) {
            const f32x4 a0 = *(const LAS f32x4*)(As + k * NG_LD + ty * 8), a1 = *(const LAS f32x4*)(As + k * NG_LD + ty * 8 + 4);
            const f32x4 b = *(const LAS f32x4*)(Bs + k * NG_LD + tx * 4);
            const float a[8] = {a0.x, a0.y, a0.z, a0.w, a1.x, a1.y, a1.z, a1.w};
#pragma unroll
            for (int i = 0; i < 8; ++i) { acc[i][0] += a[i] * b.x; acc[i][1] += a[i] * b.y; acc[i][2] += a[i] * b.z; acc[i][3] += a[i] * b.w; }
        }
    }
#pragma unroll
    for (int i = 0; i < 8; ++i) { const int r = ty * 8 + i; epi(r, rowidx[r], n0 + tx * 4, (f32x4){acc[i][0], acc[i][1], acc[i][2], acc[i][3]}); }
    __syncthreads();
}


namespace pg8 {
typedef short bf16x8 __attribute__((ext_vector_type(8)));
constexpr int BM = 256, BK = 64, HALF = 128, HTB = HALF * BK * 2;
__device__ __forceinline__ int lds_byte(int r, int c) { const int st = (r >> 4) * 2 + (c >> 5), rr = r & 15, cc = c & 31, ob = rr * 64 + cc * 2; return st * 1024 + (ob ^ (((ob >> 9) & 1) << 5)); }
__device__ __forceinline__ void stage_rc(int b, int& R, int& C) { const int st = b / 1024, sb = b % 1024, swz = sb ^ (((sb >> 9) & 1) << 5); R = (st >> 1) * 16 + swz / 64; C = (st & 1) * 32 + (swz % 64) / 2; }
__device__ __forceinline__ int perm32(int rho) { const int n = rho >> 4, i = rho & 15; return 8 * (i >> 2) + 4 * n + (i & 3); }
__device__ __forceinline__ int perm64(int R) { const int wc = R >> 5, n = (R >> 4) & 1, i = R & 15; return 64 * wc + 16 * (i >> 2) + 4 * n + (i & 3); }
struct Unit { int pm, pn, e, ct, r0, cn, sb; };
__device__ __forceinline__ unsigned cvt_pk_bf16(float lo, float hi) { unsigned r; asm volatile("v_cvt_pk_bf16_f32 %0, %1, %2" : "=v"(r) : "v"(lo), "v"(hi)); return r; }

template <bool FP8> struct FragT;
template <> struct FragT<false> {
    struct A { bf16x8 k[2]; };
    static __device__ __forceinline__ void load(A& d, const LAS unsigned char* p) { d.k[0] = *(const LAS bf16x8*)p; d.k[1] = *(const LAS bf16x8*)(p + 1024); }
    static __device__ __forceinline__ void mma(f32x4& acc, const A& b, const A& a) {
        acc = __builtin_amdgcn_mfma_f32_16x16x32_bf16(b.k[0], a.k[0], acc, 0, 0, 0); acc = __builtin_amdgcn_mfma_f32_16x16x32_bf16(b.k[1], a.k[1], acc, 0, 0, 0); }
};
typedef int i32x8 __attribute__((ext_vector_type(8)));
template <> struct FragT<true> {
    typedef i32x8 A;
    static __device__ __forceinline__ void load(A& d, const LAS unsigned char* p) { typedef int i32x4 __attribute__((ext_vector_type(4)));
        const i32x4 lo = *(const LAS i32x4*)p, hi = *(const LAS i32x4*)(p + 1024); d = __builtin_shufflevector(lo, hi, 0, 1, 2, 3, 4, 5, 6, 7); }
    static __device__ __forceinline__ void mma(f32x4& acc, const A& b, const A& a) { acc = __builtin_amdgcn_mfma_scale_f32_16x16x128_f8f6f4(b, a, acc, 0, 0, 0, 0x7f7f7f7f, 0, 0x7f7f7f7f); }
};
template <class Epi, class Sched, class RowOff, bool ALIGN_EPI, bool FP8>
__device__ __forceinline__ void gemm_phase(LAS unsigned char* lds, const bf16_t* Aptr, const bf16_t* Btptr, const Sched& S, const RowOff& RO, const Epi& E, int wid, int lane) {
    constexpr int K = 1024, ROWB = FP8 ? 1024 : 2048, nt = FP8 ? K / 128 : K / BK;
    const int tid = wid * 64 + lane, wr = wid >> 2, wc = wid & 3, fr = lane & 15, fq = lane >> 4;
    int RA[2]; unsigned CA[2], voffB[2];
#pragma unroll
    for (int i = 0; i < 2; ++i) { int R, C; stage_rc(tid * 16 + i * 8192, R, C); const int Rb = Epi::brow(R);
        RA[i] = R; CA[i] = (unsigned)C * 2u; voffB[i] = (unsigned)(Rb * ROWB + C * 2); }
    constexpr size_t kstep = (size_t)(BK * 2);
    constexpr size_t hstep = (size_t)8 * ROWB;
    constexpr size_t tstep = (size_t)BM * ROWB;
    const unsigned ldsw = (unsigned)wid * 1024u;
    const int aoff = lds_byte(wr * 64 + fr, fq * 8), boff = lds_byte(wc * 32 + fr, fq * 8);
#define PG8_SA(b, h) (((b) * 2 + (h)) * HTB)
#define PG8_SB(b, h) ((4 + (b) * 2 + (h)) * HTB)
#define PG8_STAGE(bufoff, gbase, voff) do { _Pragma("unroll") for (int _i = 0; _i < 2; ++_i) \
        __builtin_amdgcn_global_load_lds((const unsigned*)((const char*)(gbase) + (voff)[_i]), (LAS unsigned*)(lds + (bufoff) + ldsw + _i * 8192), 16, 0, 0); } while (0)
#define PG8_STAGEA(bufoff, kb, v0, v1) do { \
        __builtin_amdgcn_global_load_lds((const unsigned*)((const char*)Aptr + (size_t)(kb) + (v0)), (LAS unsigned*)(lds + (bufoff) + ldsw), 16, 0, 0); \
        __builtin_amdgcn_global_load_lds((const unsigned*)((const char*)Aptr + (size_t)(kb) + (v1)), (LAS unsigned*)(lds + (bufoff) + ldsw + 8192), 16, 0, 0); } while (0)
#define PG8_LDA(dst, b, h) do { _Pragma("unroll") for (int m = 0; m < 4; ++m) FragT<FP8>::load(dst[m], lds + PG8_SA(b, h) + aoff + m * 2048); } while (0)
#define PG8_LDB(dst, b, h) do { _Pragma("unroll") for (int n = 0; n < 2; ++n) FragT<FP8>::load(dst[n], lds + PG8_SB(b, h) + boff + n * 2048); } while (0)
#define PG8_MMA(ai, bj, At, Bt) do { __builtin_amdgcn_s_setprio(1); _Pragma("unroll") for (int m = 0; m < 4; ++m) _Pragma("unroll") for (int n = 0; n < 2; ++n) { \
        FragT<FP8>::mma(acc[ai][bj][m][n], Bt[n], At[m]); } __builtin_amdgcn_s_setprio(0); } while (0)
#define PG8_WAIT_V(n) asm volatile("s_waitcnt vmcnt(" #n ")" ::: "memory")
#define PG8_WAIT_L(n) asm volatile("s_waitcnt lgkmcnt(" #n ")" ::: "memory")
#define PG8_BAR __builtin_amdgcn_s_barrier()
#define PG8_SCHED __builtin_amdgcn_sched_barrier(0)
    Unit cur, nxt; int ui = 0;
    if (!S.next(0, cur)) return;
    f32x4 acc[2][2][4][2];
#pragma unroll
    for (int a = 0; a < 2; ++a)
#pragma unroll
        for (int b = 0; b < 2; ++b)
#pragma unroll
            for (int m = 0; m < 4; ++m)
#pragma unroll
                for (int n = 0; n < 2; ++n) acc[a][b][m][n] = (f32x4){0.f, 0.f, 0.f, 0.f};
    typename FragT<FP8>::A At[4]; typename FragT<FP8>::A B0[2], B1[2];
    unsigned c00, c01, c10, c11;
    LAS unsigned* rscr = (LAS unsigned*)(lds + 131072 + 4096 + wid * 1024);
    LAS unsigned char* escr = lds + 131072 + 4096 + 8192;
    RO.issue(cur, RA[0], RA[1], rscr); asm volatile("s_waitcnt vmcnt(0)" ::: "memory");
    RO.finish(cur, RA[0], RA[1], rscr, c00, c01, c10, c11); c00 += CA[0]; c01 += CA[1]; c10 += CA[0]; c11 += CA[1];
    const char* cB = (const char*)Btptr + (size_t)cur.pn * tstep;
    PG8_STAGE(PG8_SB(0, 0), cB, voffB); PG8_STAGE(PG8_SB(0, 1), cB + hstep, voffB); PG8_STAGEA(PG8_SA(0, 0), 0, c00, c01); PG8_STAGEA(PG8_SA(0, 1), 0, c10, c11);
    if (wr == 1) PG8_BAR;
    PG8_WAIT_V(2); PG8_BAR;
    PG8_STAGE(PG8_SB(1, 0), cB + kstep, voffB); PG8_STAGEA(PG8_SA(1, 0), kstep, c00, c01); PG8_STAGE(PG8_SB(1, 1), cB + hstep + kstep, voffB);
    PG8_WAIT_V(6); PG8_BAR;
    for (;;) {
        const bool has_next = S.next(ui + 1, nxt);
        E.issue(cur, escr + (ui & 1) * 3072, wid, lane);
        if (has_next) RO.issue(nxt, RA[0], RA[1], rscr);
        const char* nB = has_next ? (const char*)Btptr + (size_t)nxt.pn * tstep : cB;
#pragma unroll 1
        for (int t = 0; t < nt; t += 2) {
            const bool last = (t == nt - 2);
            const size_t k1 = (size_t)(t + 1) * kstep;
            const size_t k2 = last ? 0 : (size_t)(t + 2) * kstep, k3 = k2 + kstep;
            const char* b2 = last ? nB : cB + (size_t)(t + 2) * kstep; const char* b3 = b2 + kstep;
            PG8_LDB(B0, 0, 0); PG8_LDB(B1, 0, 1); PG8_SCHED; PG8_LDA(At, 0, 0); PG8_STAGEA(PG8_SA(1, 1), k1, c10, c11);
            E.touch(cur, t, escr, wid, lane);
            if (last && has_next) { RO.finish(nxt, RA[0], RA[1], rscr, c00, c01, c10, c11); c00 += CA[0]; c01 += CA[1]; c10 += CA[0]; c11 += CA[1]; }
            PG8_WAIT_V(8); PG8_WAIT_L(0); PG8_BAR; PG8_MMA(0, 0, At, B0); PG8_MMA(0, 1, At, B1); PG8_BAR; PG8_SCHED;
            PG8_LDA(At, 0, 1); PG8_STAGE(PG8_SB(0, 0), b2, voffB); PG8_STAGE(PG8_SB(0, 1), b2 + hstep, voffB); PG8_STAGEA(PG8_SA(0, 0), k2, c00, c01);
            PG8_WAIT_V(8); PG8_WAIT_L(0); PG8_BAR; PG8_MMA(1, 0, At, B0); PG8_MMA(1, 1, At, B1); PG8_BAR; PG8_SCHED;
            PG8_LDB(B0, 1, 0); PG8_LDB(B1, 1, 1); PG8_SCHED; PG8_LDA(At, 1, 0); PG8_STAGEA(PG8_SA(0, 1), k2, c10, c11);
            PG8_WAIT_V(8); PG8_WAIT_L(0); PG8_BAR; PG8_MMA(0, 0, At, B0); PG8_MMA(0, 1, At, B1); PG8_BAR; PG8_SCHED;
            PG8_LDA(At, 1, 1); PG8_STAGE(PG8_SB(1, 0), b3, voffB); PG8_STAGE(PG8_SB(1, 1), b3 + hstep, voffB); PG8_STAGEA(PG8_SA(1, 0), k3, c00, c01);
            PG8_WAIT_V(8); PG8_WAIT_L(0); PG8_BAR; PG8_MMA(1, 0, At, B0); PG8_MMA(1, 1, At, B1); PG8_BAR; PG8_SCHED;
        }
        if constexpr (ALIGN_EPI) { if (wr == 0) PG8_BAR; }
        E(acc, cur, wr, wc, fr, fq, escr + (ui & 1) * 3072, (LAS unsigned char*)rscr, lds + 131072 + 4096 + 8192 + 6144 + wid * 1024);
        if (!has_next) break;
#pragma unroll
        for (int a = 0; a < 2; ++a)
#pragma unroll
            for (int b = 0; b < 2; ++b)
#pragma unroll
                for (int m = 0; m < 4; ++m)
#pragma unroll
                    for (int n = 0; n < 2; ++n) acc[a][b][m][n] = (f32x4){0.f, 0.f, 0.f, 0.f};
        cur = nxt; cB = nB; ++ui;
        if constexpr (ALIGN_EPI) { if (wr == 1) PG8_BAR; }
    }
    PG8_WAIT_V(0);
    if constexpr (!ALIGN_EPI) { if (wr == 0) PG8_BAR; }
    PG8_BAR;
#undef PG8_SA
#undef PG8_SB
#undef PG8_STAGE
#undef PG8_STAGEA
#undef PG8_LDA
#undef PG8_LDB
#undef PG8_MMA
#undef PG8_WAIT_V
#undef PG8_WAIT_L
#undef PG8_BAR
#undef PG8_SCHED
}

struct DenseOrder {
    int nM, nN, nwg, G, c;
    __device__ void init(int M, int N, int G_, int c_) { nM = M / BM; nN = N / BM; nwg = nM * nN; G = G_; c = c_; }
    __device__ bool next(int i, Unit& u) const {
        const long L = (long)i * G + c; if (L >= nwg) return false;
        int wgid = (int)L; { const int q = nwg / 8, r = nwg % 8, xcd = wgid % 8, off = wgid / 8; wgid = (xcd < r ? xcd * (q + 1) : r * (q + 1) + (xcd - r) * q) + off; }
        const int nig = 8 * nN, gid = wgid / nig, fm = gid * 8, gsz = (nM - fm) < 8 ? (nM - fm) : 8;
        u.pm = fm + ((wgid % nig) % gsz); u.pn = (wgid % nig) / gsz; u.e = 0; u.ct = u.pn; u.r0 = 0; u.cn = 0; u.sb = 0; return true;
    }
};
struct MoeOrder {
    const LAS int* meta; int nct, G, c, nunits;
    __device__ bool next(int i, Unit& u) const {
        const int x = c & 7, y = c >> 3, rpx = 32 / nct;
        const int rt = i * 8 * rpx + x * rpx + (y % rpx), ct = y / rpx;
        if (rt >= nunits / nct) return false;
        int e = 0;
        for (int q = 1; q < NE; ++q) if (meta[q] <= rt) e = q;
        u.e = e; u.ct = ct; u.r0 = (rt - meta[e]) * BM; u.cn = meta[128 + e]; u.sb = meta[64 + e]; u.pm = (u.sb + u.r0) / BM; u.pn = e * nct + ct; return true;
    }
};
struct RowDense { unsigned rowb;
    __device__ __forceinline__ void issue(const Unit&, int, int, LAS unsigned*) const {}
    __device__ __forceinline__ void finish(const Unit& u, int R0, int R1, LAS unsigned*, unsigned& o00, unsigned& o01, unsigned& o10, unsigned& o11) const {
    const unsigned base = (unsigned)u.pm * BM; o00 = (base + R0) * rowb; o01 = (base + R1) * rowb; o10 = (base + 128 + R0) * rowb; o11 = (base + 128 + R1) * rowb; } };
struct RowGather { const int* ltok; unsigned rowb;
    __device__ __forceinline__ void issue(const Unit& u, int R0, int R1, LAS unsigned* scr) const {
        const int* lp = ltok + (size_t)u.e * T + u.r0; const int lim = u.cn - u.r0 - 1;
        const int i00 = R0 < lim ? R0 : lim, i01 = R1 < lim ? R1 : lim, i10 = 128 + R0 < lim ? 128 + R0 : lim, i11 = 128 + R1 < lim ? 128 + R1 : lim;
        __builtin_amdgcn_global_load_lds((const unsigned*)(lp + i00), scr, 4, 0, 0); __builtin_amdgcn_global_load_lds((const unsigned*)(lp + i01), scr + 64, 4, 0, 0);
        __builtin_amdgcn_global_load_lds((const unsigned*)(lp + i10), scr + 128, 4, 0, 0); __builtin_amdgcn_global_load_lds((const unsigned*)(lp + i11), scr + 192, 4, 0, 0); }
    __device__ __forceinline__ void finish(const Unit&, int, int, LAS unsigned* scr, unsigned& o00, unsigned& o01, unsigned& o10, unsigned& o11) const {
        const int lane_ = (int)__builtin_amdgcn_mbcnt_hi(~0u, __builtin_amdgcn_mbcnt_lo(~0u, 0u));
        o00 = scr[lane_] * rowb; o01 = scr[64 + lane_] * rowb; o10 = scr[128 + lane_] * rowb; o11 = scr[192 + lane_] * rowb; } };
__device__ __forceinline__ u32x4 quad_rows(const u32x4 w, LAS unsigned char* tscr, int fr, int fq, int l) {
    *(LAS u32x4*)(tscr + (4 * fr + (fq ^ ((fr >> 1) & 3))) * 16) = w;
    return *(const LAS u32x4*)(tscr + ((l & ~3) + ((l & 3) ^ ((l >> 3) & 3))) * 16);
}
__device__ __forceinline__ void line_rows(const u32x4 w0, const u32x4 w1, u32x4& o0, u32x4& o1, LAS unsigned char* t0, LAS unsigned char* t1, int fr, int fq, int l) {
    LAS unsigned char* wp = ((fr & 8) ? t1 : t0) + (fr & 7) * 128;
    *(LAS u32x4*)(wp + (((2 * fq) ^ (fr & 7)) * 16)) = w0; *(LAS u32x4*)(wp + (((2 * fq + 1) ^ (fr & 7)) * 16)) = w1;
    const int ro = (l >> 3) * 128 + (((l & 7) ^ (l >> 3)) * 16);
    o0 = *(const LAS u32x4*)(t0 + ro); o1 = *(const LAS u32x4*)(t1 + ro);
}
struct EpiProj { bf16_t* O;
    static __device__ __forceinline__ int brow(int R) { return perm64(R); }
    __device__ __forceinline__ void issue(const Unit&, LAS unsigned char*, int, int) const {}
    __device__ __forceinline__ void touch(const Unit&, int, LAS unsigned char*, int, int) const {}
    __device__ __forceinline__ void operator()(const f32x4 (&acc)[2][2][4][2], const Unit& u, int wr, int wc, int fr, int fq, const LAS unsigned char*, LAS unsigned char* t0, LAS unsigned char* t1) const {
        asm volatile("" : "+v"(fr), "+v"(fq));
        const int l = fr + 16 * fq;
        bf16_t* op = O + (size_t)(u.pm * BM + wr * 64 + (l >> 3)) * INC + u.ct * BM + wc * 64 + 8 * (l & 7);
#pragma unroll
        for (int ai = 0; ai < 2; ++ai)
#pragma unroll
            for (int m = 0; m < 4; ++m) { u32x4 w[2], o0, o1;
#pragma unroll
                for (int bj = 0; bj < 2; ++bj) { const f32x4 v0 = acc[ai][bj][m][0], v1 = acc[ai][bj][m][1];
                    w[bj].x = cvt_pk_bf16(v0[0], v0[1]); w[bj].y = cvt_pk_bf16(v0[2], v0[3]); w[bj].z = cvt_pk_bf16(v1[0], v1[1]); w[bj].w = cvt_pk_bf16(v1[2], v1[3]); }
                line_rows(w[0], w[1], o0, o1, t0, t1, fr, fq, l);
                bf16_t* rp = op + (size_t)(ai * HALF + m * 16) * INC; *(u32x4*)rp = o0; *(u32x4*)(rp + (size_t)8 * INC) = o1; }
    } };
struct EpiOut { const float* X; bf16_t* H;
    static __device__ __forceinline__ int brow(int R) { return perm64(R); }
    __device__ __forceinline__ void issue(const Unit&, LAS unsigned char*, int, int) const {}
    __device__ __forceinline__ void touch(const Unit& u, int t, LAS unsigned char* scr, int wid, int lane) const {
        if ((t & 3) == 0) { const int idx = ((t >> 2) * 8 + wid) * 64 + lane;
            __builtin_amdgcn_global_load_lds((const unsigned*)(X + (size_t)(u.pm * BM + (idx >> 3)) * D + u.ct * BM + (idx & 7) * 32), (LAS unsigned*)(scr + wid * 256), 4, 0, 0); } }
    static __device__ __forceinline__ int gperm(int r) { return ((r >> 1) & 1) | ((r & 1) << 1) | (r & 4); }
    __device__ __forceinline__ void operator()(const f32x4 (&acc)[2][2][4][2], const Unit& u, int wr, int wc, int fr, int fq, const LAS unsigned char*, LAS unsigned char* t0, LAS unsigned char* t1) const {
        asm volatile("" : "+v"(fr), "+v"(fq));
        const int l = fr + 16 * fq;
        LAS unsigned char* wb = ((fq >> 1) ? t1 : t0) + (fr & 7) * 128; const int gw = gperm(fr & 7), wc0 = 4 * (fq & 1);
        const int rr = l >> 3, cp = l & 7, gr = gperm(rr);
        const LAS unsigned char* rb = ((cp >> 2) ? t1 : t0) + rr * 128; const int ra0 = ((2 * (cp & 3)) ^ gr) * 16, ra1 = ((2 * (cp & 3) + 1) ^ gr) * 16;
        const size_t gro = (size_t)(u.pm * BM + wr * 64 + rr) * D + u.ct * BM + wc * 64 + 8 * cp;
        const float* xp = X + gro; bf16_t* hp = H + gro;
        f32x4 xa[2][2];
#define EO_RO(i) ((size_t)((((i) >> 3) * HALF + (((i) >> 1) & 3) * 16 + 8 * ((i) & 1)) * D))
        xa[0][0] = *(const f32x4*)(xp + EO_RO(0)); xa[0][1] = *(const f32x4*)(xp + EO_RO(0) + 4); xa[1][0] = *(const f32x4*)(xp + EO_RO(1)); xa[1][1] = *(const f32x4*)(xp + EO_RO(1) + 4);
#pragma unroll
        for (int i = 0; i < 16; ++i) { const int ai = i >> 3, m = (i >> 1) & 3, p = i & 1;
            if ((fr >> 3) == p) {
#pragma unroll
                for (int j = 0; j < 4; ++j) *(LAS f32x4*)(wb + (((wc0 + j) ^ gw) * 16)) = acc[ai][j >> 1][m][j & 1]; }
            const f32x4 v0 = *(const LAS f32x4*)(rb + ra0) + xa[i & 1][0], v1 = *(const LAS f32x4*)(rb + ra1) + xa[i & 1][1];
            if (i + 2 < 16) { xa[i & 1][0] = *(const f32x4*)(xp + EO_RO(i + 2)); xa[i & 1][1] = *(const f32x4*)(xp + EO_RO(i + 2) + 4); }
            u32x4 w; w.x = cvt_pk_bf16(v0[0], v0[1]); w.y = cvt_pk_bf16(v0[2], v0[3]); w.z = cvt_pk_bf16(v1[0], v1[1]); w.w = cvt_pk_bf16(v1[2], v1[3]);
            *(u32x4*)(hp + EO_RO(i)) = w; }
#undef EO_RO
    } };
struct EpiUp { bf16_t* ACTp; const float* bup; float wscale;
    static __device__ __forceinline__ int brow(int R) { const int p = perm64(R); return (p & ~3) | ((p & 1) << 1) | ((p >> 1) & 1); }
    __device__ __forceinline__ void issue(const Unit& u, LAS unsigned char* scr, int wid, int lane) const {
        if (wid == 0) __builtin_amdgcn_global_load_lds((const unsigned*)(bup + (size_t)u.e * 2 * DFF + u.ct * BM + 4 * lane), (LAS unsigned*)scr, 16, 0, 0); }
    __device__ __forceinline__ void touch(const Unit&, int, LAS unsigned char*, int, int) const {}
    __device__ __forceinline__ void operator()(const f32x4 (&acc)[2][2][4][2], const Unit& u, int wr, int wc, int fr, int fq, const LAS unsigned char* scr, LAS unsigned char* t0, LAS unsigned char*) const {
        asm volatile("" : "+v"(fr), "+v"(fq));
        typedef float f32x2 __attribute__((ext_vector_type(2)));
        const int l = fr + 16 * fq;
        const LAS float* bp = (const LAS float*)scr + wc * 64 + 16 * fq;
        f32x4 bb[4];
#pragma unroll
        for (int j = 0; j < 4; ++j) { const f32x4 t = *(const LAS f32x4*)(bp + 4 * j); bb[j] = (f32x4){t.x, t.z, t.y, t.w}; asm volatile("" : "+v"(bb[j])); }
        const int ro = (l >> 1) * 32 + (((l & 1) ^ ((l >> 3) & 1)) * 16);
        const int rl1 = wr * 64 + (l >> 1);
        unsigned char* op = (unsigned char*)ACTp + (size_t)(u.sb + u.r0 + rl1) * DFF + u.ct * (BM / 2) + wc * 32 + 16 * (l & 1);
        const f32x2 c7 = {7.f, 7.f}, one = {1.f, 1.f}; const float ke = -1.702f * 1.4426950408889634f;
#pragma unroll
        for (int q = 0; q < 4; ++q) { const int ai = q >> 1;
#pragma unroll
            for (int mm = 0; mm < 2; ++mm) { const int m = 2 * (q & 1) + mm; u32x2 w8; w8.x = 0u; w8.y = 0u;
                if (u.r0 + wr * 64 + fr + ai * HALF + m * 16 < u.cn) {
#pragma unroll
                    for (int bj = 0; bj < 2; ++bj) { f32x2 a[2];
#pragma unroll
                        for (int n = 0; n < 2; ++n) { const f32x4 v = acc[ai][bj][m][n] * wscale + bb[2 * bj + n];
                            const f32x2 gl = {fminf(v.x, 7.f), fminf(v.y, 7.f)}, li = {__builtin_amdgcn_fmed3f(v.z, -7.f, 7.f), __builtin_amdgcn_fmed3f(v.w, -7.f, 7.f)};
                            const f32x2 ex = gl * ke; const f32x2 dn = (f32x2){__builtin_amdgcn_exp2f(ex.x), __builtin_amdgcn_exp2f(ex.y)} + one;
                            a[n] = gl * (li + one) * (f32x2){__builtin_amdgcn_rcpf(dn.x), __builtin_amdgcn_rcpf(dn.y)}; }
                        int t8 = __builtin_amdgcn_cvt_pk_fp8_f32(a[0].x, a[0].y, 0, false); t8 = __builtin_amdgcn_cvt_pk_fp8_f32(a[1].x, a[1].y, t8, true);
                        if (bj) w8.y = (unsigned)t8; else w8.x = (unsigned)t8; } }
                const int row = 16 * mm + fr;
                *(LAS u32x2*)(t0 + row * 32 + ((fq ^ (((row >> 2) & 1) * 2)) * 8)) = w8; }
            const u32x4 o = *(const LAS u32x4*)(t0 + ro);
            const int rl = rl1 + ai * HALF + 32 * (q & 1);
            if (u.r0 + rl < u.cn) *(u32x4*)(op + (size_t)(ai * HALF + 32 * (q & 1)) * DFF) = o; }
    } };
struct EpiDown { bf16_t* YKp; const float* bdn; const int* ldst; const float* lgate; float wscale;
    static __device__ __forceinline__ int brow(int R) { return perm64(R); }
    __device__ __forceinline__ void issue(const Unit& u, LAS unsigned char* scr, int wid, int lane) const {
        const size_t li = (size_t)u.e * T + u.r0 + 4 * lane;
        if (wid == 0) __builtin_amdgcn_global_load_lds((const unsigned*)(bdn + (size_t)u.e * D + u.ct * BM + 4 * lane), (LAS unsigned*)scr, 16, 0, 0);
        else if (wid == 1) __builtin_amdgcn_global_load_lds((const unsigned*)(lgate + li), (LAS unsigned*)(scr + 1024), 16, 0, 0);
        else if (wid == 2) __builtin_amdgcn_global_load_lds((const unsigned*)(ldst + li), (LAS unsigned*)(scr + 2048), 16, 0, 0); }
    __device__ __forceinline__ void touch(const Unit&, int, LAS unsigned char*, int, int) const {}
    __device__ __forceinline__ void operator()(const f32x4 (&acc)[2][2][4][2], const Unit& u, int wr, int wc, int fr, int fq, const LAS unsigned char* scr, LAS unsigned char* t0, LAS unsigned char*) const {
        asm volatile("" : "+v"(fr), "+v"(fq));
        const int l = fr + 16 * fq;
        const LAS float* bp = (const LAS float*)scr + wc * 64 + 16 * fq; const LAS float* gp = (const LAS float*)(scr + 1024); const LAS int* dp = (const LAS int*)(scr + 2048);
        const f32x4 b00 = *(const LAS f32x4*)(bp), b01 = *(const LAS f32x4*)(bp + 4), b10 = *(const LAS f32x4*)(bp + 8), b11 = *(const LAS f32x4*)(bp + 12);
        const int rl0 = wr * 64 + fr, rl1 = wr * 64 + (l >> 2), colb = u.ct * BM + wc * 64 + 16 * (l & 3);
#pragma unroll
        for (int q = 0; q < 8; ++q) { const int ai = q >> 2, m = q & 3;
            const float g = gp[rl0 + ai * HALF + m * 16] * 16.f;
            u32x4 w;
#pragma unroll
            for (int bj = 0; bj < 2; ++bj) { const f32x4 v0 = (acc[ai][bj][m][0] * wscale + (bj ? b10 : b00)) * g, v1 = (acc[ai][bj][m][1] * wscale + (bj ? b11 : b01)) * g;
                int lo = __builtin_amdgcn_cvt_pk_fp8_f32(v0[0], v0[1], 0, false); lo = __builtin_amdgcn_cvt_pk_fp8_f32(v0[2], v0[3], lo, true);
                int hi = __builtin_amdgcn_cvt_pk_fp8_f32(v1[0], v1[1], 0, false); hi = __builtin_amdgcn_cvt_pk_fp8_f32(v1[2], v1[3], hi, true);
                if (bj) { w.z = (unsigned)lo; w.w = (unsigned)hi; } else { w.x = (unsigned)lo; w.y = (unsigned)hi; } }
            const u32x4 o = quad_rows(w, t0, fr, fq, l);
            const int rl = rl1 + ai * HALF + m * 16;
            if (u.r0 + rl < u.cn) *(u32x4*)((unsigned char*)YKp + (size_t)dp[rl] * D + colb) = o; }
    } };
}

__device__ __forceinline__ void transpose_item(const float* W, int K, int N, bf16_t* WT, LAS float*, int item, int lane) {
    const int nblk = N / 32, kb = item / nblk, nb = item % nblk, k0 = 64 * kb + 8 * (lane >> 3), n0 = 32 * nb + 4 * (lane & 7);
    f32x4 wv[8];
#pragma unroll
    for (int i = 0; i < 8; ++i) wv[i] = *(const f32x4*)(W + (size_t)(k0 + i) * N + n0);
#pragma unroll
    for (int q = 0; q < 4; ++q) { u32x4 o; o.x = pk2(wv[0][q], wv[1][q]); o.y = pk2(wv[2][q], wv[3][q]); o.z = pk2(wv[4][q], wv[5][q]); o.w = pk2(wv[6][q], wv[7][q]);
        *(u32x4*)(WT + (size_t)(n0 + q) * K + k0) = o; }
}

struct CvItem { const float* src; unsigned char* dst; int N, K; };
__device__ __forceinline__ CvItem cv_item(int r, const float* wup, const float* wdn, unsigned char* WUP8, unsigned char* WDN8, int lane) {
    constexpr int I_UP = 16 * (2 * DFF / 32), I_DN = 16 * (D / 32);
    CvItem it; const float* W; unsigned char* WT; int item;
    if (r < NE * I_UP) { const int e = r / I_UP; W = wup + (size_t)e * D * 2 * DFF; WT = WUP8 + (size_t)e * 2 * DFF * D; it.K = D; it.N = 2 * DFF; item = r % I_UP; }
    else { r -= NE * I_UP; const int e = r / I_DN; W = wdn + (size_t)e * DFF * D; WT = WDN8 + (size_t)e * D * DFF; it.K = DFF; it.N = D; item = r % I_DN; }
    const int nblk = it.N / 32, kb = item / nblk, nb = item % nblk, k0 = 64 * kb, n0 = 32 * nb;
    it.src = W + (size_t)(k0 + 8 * (lane >> 3)) * it.N + n0 + 4 * (lane & 7);
    it.dst = WT + (size_t)(n0 + 4 * (lane & 7)) * it.K + k0 + 8 * (lane >> 3);
    return it;
}
__device__ __forceinline__ void cv_load(f32x4 (&wv)[8], const CvItem& it) {
#pragma unroll
    for (int i = 0; i < 8; ++i) wv[i] = *(const f32x4*)(it.src + (size_t)i * it.N);
}
__device__ __forceinline__ void cv_finish(const f32x4 (&wv)[8], const CvItem& it, LAS float*, int) {
#pragma unroll
    for (int q = 0; q < 4; ++q) {
        int lo = __builtin_amdgcn_cvt_pk_fp8_f32(wv[0][q] * 32.f, wv[1][q] * 32.f, 0, false); lo = __builtin_amdgcn_cvt_pk_fp8_f32(wv[2][q] * 32.f, wv[3][q] * 32.f, lo, true);
        int hi = __builtin_amdgcn_cvt_pk_fp8_f32(wv[4][q] * 32.f, wv[5][q] * 32.f, 0, false); hi = __builtin_amdgcn_cvt_pk_fp8_f32(wv[6][q] * 32.f, wv[7][q] * 32.f, hi, true);
        u32x2 o; o.x = (unsigned)lo; o.y = (unsigned)hi;
        *(u32x2*)(it.dst + (size_t)q * it.K) = o; }
}

constexpr int CV_PER = 64, CV_ITEMS = NE * (16 * (2 * DFF / 32) + 16 * (D / 32)), CV_TICKETS = CV_ITEMS / CV_PER;
__device__ __forceinline__ void convert_ticket(int ticket, const float* wup, const float* wdn, unsigned char* WUP8, unsigned char* WDN8, LAS float* scr, int wave, int lane) {
    const int base = ticket * CV_PER + wave;
    f32x4 wa[8], wb[8];
    CvItem ia = cv_item(base, wup, wdn, WUP8, WDN8, lane), ib;
    cv_load(wa, ia);
#pragma unroll 1
    for (int j = 0; j < CV_PER / NWAVES; j += 2) {
        ib = cv_item(base + (j + 1) * NWAVES, wup, wdn, WUP8, WDN8, lane); cv_load(wb, ib);
        cv_finish(wa, ia, scr, lane);
        if (j + 2 < CV_PER / NWAVES) { ia = cv_item(base + (j + 2) * NWAVES, wup, wdn, WUP8, WDN8, lane); cv_load(wa, ia); }
        cv_finish(wb, ib, scr, lane);
    }
}

namespace rk {
__device__ __forceinline__ unsigned hpk(float lo, float hi) { return pk2(lo, hi); }
typedef short bf16x8 __attribute__((ext_vector_type(8)));
typedef float f32x16 __attribute__((ext_vector_type(16)));
constexpr int RS64 = 144, RS32 = 80;
__device__ __forceinline__ bf16x8 frag(const LAS unsigned char* base, int RS, int row0, int k0, int r32, int hi) { return *(const LAS bf16x8*)(base + (row0 + r32) * RS + (k0 + 8 * hi) * 2); }
__device__ __forceinline__ bf16x8 negf(bf16x8 a) { u32x4 w = __builtin_bit_cast(u32x4, a); w.x ^= 0x80008000u; w.y ^= 0x80008000u; w.z ^= 0x80008000u; w.w ^= 0x80008000u; return __builtin_bit_cast(bf16x8, w); }
template <int NK, bool NEG> __device__ __forceinline__ void mm(f32x16& acc, const LAS unsigned char* A, int ARS, int arow0, const LAS unsigned char* B, int BRS, int brow0, int r32, int hi) {
#pragma unroll
    for (int s = 0; s < NK; ++s) { bf16x8 a = frag(A, ARS, arow0, 16 * s, r32, hi); if (NEG) a = negf(a);
        acc = __builtin_amdgcn_mfma_f32_32x32x16_bf16(a, frag(B, BRS, brow0, 16 * s, r32, hi), acc, 0, 0, 0); }
}
__device__ __forceinline__ void tstore(const f32x16& acc, LAS unsigned char* base, int RS, int drow0, int dcol0, int r32, int hi) {
#pragma unroll
    for (int g = 0; g < 4; ++g) { u32x2 w; w.x = hpk(acc[4 * g], acc[4 * g + 1]); w.y = hpk(acc[4 * g + 2], acc[4 * g + 3]);
        *(LAS u32x2*)(base + (drow0 + r32) * RS + (dcol0 + 8 * g + 4 * hi) * 2) = w; }
}
__device__ __forceinline__ void tload(f32x16& acc, const LAS unsigned char* base, int RS, int drow0, int dcol0, int r32, int hi) {
#pragma unroll
    for (int g = 0; g < 4; ++g) { const u32x2 w = *(const LAS u32x2*)(base + (drow0 + r32) * RS + (dcol0 + 8 * g + 4 * hi) * 2);
        acc[4 * g] = bf2f(w.x & 0xffff); acc[4 * g + 1] = bf2f(w.x >> 16); acc[4 * g + 2] = bf2f(w.y & 0xffff); acc[4 * g + 3] = bf2f(w.y >> 16); }
}
__device__ __forceinline__ f32x16 zero16() { f32x16 z;
#pragma unroll
    for (int r = 0; r < 16; ++r) z[r] = 0.f; return z; }
constexpr int OFF_KKD = 0, OFF_RD = 4608, OFF_BI = 9216, OFF_KI = 13824;
constexpr int OFF_KKDT = 18432, OFF_BIT = 23552, OFF_KIT = 28672, OFF_VT = 33792;
constexpr int OFF_P0 = 38912, OFF_P1 = 41472, OFF_PT0 = 44032, OFF_PT1 = 46592, OFF_X0 = 49152, OFF_X1 = 51712, OFF_AK = 54272, OFF_BRB = 56832, OFF_BRK = 59392;
constexpr int OFF_AKVT = 61952, OFF_GAM = 67072, SLOT = 67328;
constexpr int OFF_Q1 = OFF_KKD, OFF_G = OFF_BI, OFF_P1T = OFF_P0, OFF_P2T = OFF_P0 + 5120, OFF_YB = OFF_KKDT, OFF_WT = OFF_P0;
constexpr int OFF_M0 = 2 * SLOT, OFF_M1 = OFF_X0  , LDS_END = OFF_M0 + 9216;
static_assert(LDS_END <= LDS_BYTES - 64, "rwkv LDS map");
}

#define XB_TMO      128
#define XB_XCNT(j)  (256  + 64 * (j))
#define XB_XSUB(j)  (1280 + 64 * (j))
#define XB_XGEN(j)  (2304 + 64 * (j))
#define XB_TOP      3328
#define XB_TOPGEN   3392
#define XCD_BAR_WORDS 3456
#define XB_SPIN_CAP (1u << 18)
__device__ __forceinline__ unsigned xb_ld(unsigned* p)              { return __hip_atomic_load(p, __ATOMIC_RELAXED, __HIP_MEMORY_SCOPE_AGENT); }
__device__ __forceinline__ unsigned xb_add(unsigned* p, unsigned v) { return __hip_atomic_fetch_add(p, v, __ATOMIC_RELAXED, __HIP_MEMORY_SCOPE_AGENT); }
__device__ __forceinline__ unsigned xb_xcc_id() { return (unsigned)__builtin_amdgcn_s_getreg((3 << 11) | 20) & 0xFu; }
#define XB_SPIN(cond, bar) do { unsigned _sp = 0; while (cond) { __builtin_amdgcn_s_sleep(1); \
    if ((++_sp & 255u) == 0u) { if (xb_ld(&(bar)[XB_TMO])) break; if (_sp > XB_SPIN_CAP) { atomicAdd(&(bar)[XB_TMO], 1u); break; } } } } while (0)
struct XcdBarrier { unsigned* bar; unsigned x; volatile LAS unsigned* st; };
__device__ __forceinline__ XcdBarrier xcd_barrier_post(unsigned* bar, volatile LAS unsigned* st) {
    XcdBarrier b; b.bar = bar; b.x = xb_xcc_id(); b.st = st;
    if (threadIdx.x == 0) (void)xb_add(&bar[XB_XCNT(b.x)], 1u);
    return b;
}
__device__ __forceinline__ void xcd_barrier_complete(unsigned* bar, unsigned x, unsigned& nloc, unsigned& nx) {
    const unsigned G = gridDim.x * gridDim.y * gridDim.z;
    unsigned sum, cnt, mine, sp = 0u;
    for (;;) {
        sum = 0u; cnt = 0u; mine = 0u;
#pragma unroll
        for (unsigned j = 0; j < 16; ++j) { const unsigned c = xb_ld(&bar[XB_XCNT(j)]); sum += c; cnt += (c > 0u) ? 1u : 0u; mine = (j == x) ? c : mine; }
        if (sum == G) break;
        __builtin_amdgcn_s_sleep(1);
        if ((++sp & 255u) == 0u) { if (xb_ld(&bar[XB_TMO])) break; if (sp > XB_SPIN_CAP) { atomicAdd(&bar[XB_TMO], 1u); break; } }
    }
    nloc = mine > 0u ? mine : 1u; nx = cnt > 0u ? cnt : 1u;
}
__device__ __forceinline__ void xcd_barrier(const XcdBarrier& b, int wave_) {
    asm volatile("s_waitcnt vmcnt(0)" ::: "memory");
    __syncthreads();
    if (wave_ == 0 && __builtin_amdgcn_mbcnt_hi(~0u, __builtin_amdgcn_mbcnt_lo(~0u, 0u)) == 0) {
        unsigned* bar = b.bar;
        __builtin_amdgcn_s_waitcnt(0);
        unsigned nloc = b.st[0], nx = b.st[1];
        if (nloc == 0u) { xcd_barrier_complete(bar, b.x, nloc, nx); b.st[0] = nloc; b.st[1] = nx; }
        const unsigned old = xb_add(&bar[XB_XSUB(b.x)], 1u);
        const unsigned gen = old / nloc;
        if (old + 1u == (gen + 1u) * nloc) {
            __builtin_amdgcn_fence(__ATOMIC_RELEASE, "agent");
            asm volatile("s_waitcnt vmcnt(0)" ::: "memory");
            const unsigned og = xb_add(&bar[XB_TOP], 1u);
            const unsigned tg = og / nx;
            if (og + 1u == (tg + 1u) * nx) xb_add(&bar[XB_TOPGEN], 1u);
            else XB_SPIN(xb_ld(&bar[XB_TOPGEN]) == tg, bar);
            __builtin_amdgcn_fence(__ATOMIC_ACQUIRE, "agent");
            xb_add(&bar[XB_XGEN(b.x)], 1u);
            asm volatile("s_waitcnt vmcnt(0)" ::: "memory");
        } else {
            XB_SPIN(xb_ld(&bar[XB_XGEN(b.x)]) == gen, bar);
            __builtin_amdgcn_fence(__ATOMIC_ACQUIRE, "agent");
            asm volatile("s_waitcnt vmcnt(0)" ::: "memory");
        }
    }
    __syncthreads();
}
constexpr int CW_TICKET2 = 128;
constexpr int CW_TICKET = 64;
constexpr int CW_BAR = 4096;
constexpr int LDS_BARST = LDS_BYTES - 64;

#define PHASE_PTRS \
    const int G = gridDim.x, bid = blockIdx.x; const int gw = bid * NWAVES + wave, NGW = G * NWAVES; (void)gw; (void)NGW; (void)G; (void)bid; \
    const int lane = (int)__builtin_amdgcn_mbcnt_hi(~0u, __builtin_amdgcn_mbcnt_lo(~0u, 0u)); const int tid = wave * 64 + lane; (void)tid; \
    const __attribute__((address_space(4))) Args* A_ = (const __attribute__((address_space(4))) Args*)__builtin_amdgcn_kernarg_segment_ptr(); asm volatile("" : "+s"(A_)); \
    unsigned char* ws = A_->ws; const float* const __attribute__((address_space(4)))* AIN = A_->in; const float* x = AIN[0]; float* OUT = A_->out; \
    unsigned* ctl = (unsigned*)(ws + WS_CTL); unsigned* cnt = ctl; \
    int* ltok = (int*)(ws + WS_LTOK); int* ldst = (int*)(ws + WS_LDST); float* lgate = (float*)(ws + WS_LGATE); \
    bf16_t* XN = (bf16_t*)(ws + WS_XN); bf16_t* Y = (bf16_t*)(ws + WS_Y); bf16_t* H1 = (bf16_t*)(ws + WS_H1); \
    bf16_t* PROJ = (bf16_t*)(ws + WS_PROJ); \
    bf16_t *WIN = (bf16_t*)(ws + WS_WIN), *WOUT = (bf16_t*)(ws + WS_WOUT), *WDN = (bf16_t*)(ws + WS_WDN), *WUP = (bf16_t*)(ws + WS_WUP); \
    bf16_t *RR = (bf16_t*)(ws + WS_RR), *RK = (bf16_t*)(ws + WS_RK), *RV = (bf16_t*)(ws + WS_RV), *RKK = (bf16_t*)(ws + WS_RKK), *RB = (bf16_t*)(ws + WS_RB), *RG = (bf16_t*)(ws + WS_RG); \
    float* RWd = (float*)(ws + WS_RW); float* RKD = (float*)(ws + WS_RKD); bf16_t* REC = (bf16_t*)(ws + WS_REC); (void)REC; \
    bf16_t* OC = (bf16_t*)(ws + WS_OC); bf16_t* ACT = (bf16_t*)(ws + WS_ACT); bf16_t* YK = (bf16_t*)(ws + WS_YK); \
    (void)x; (void)OUT; (void)cnt; (void)ltok; (void)ldst; (void)lgate; (void)XN; (void)Y; (void)H1; (void)PROJ; (void)WIN; (void)WOUT; (void)WDN; (void)WUP; \
    (void)RR; (void)RK; (void)RV; (void)RKK; (void)RB; (void)RG; (void)RWd; (void)RKD; (void)OC; (void)ACT; (void)YK; (void)AIN;

__global__ void __launch_bounds__(NTHREADS, 2) mk_fwd(Args args) {
    extern __shared__ __attribute__((aligned(16))) unsigned char lds_raw[];
    LAS unsigned char* lds = (LAS unsigned char*)lds_raw;
    const int wave = __builtin_amdgcn_readfirstlane(threadIdx.x >> 6);
    unsigned* ctl = (unsigned*)(args.ws + WS_CTL);
    const int lo = args.ph_lo, hi = args.ph_hi;
    if (threadIdx.x < 16) ((LAS unsigned*)(lds + LDS_BARST))[threadIdx.x] = 0u;
    __syncthreads();
    XcdBarrier gbar; gbar.bar = ctl + CW_BAR; gbar.x = 0; gbar.st = (volatile LAS unsigned*)(lds + LDS_BARST);
    if (hi - lo > 1) gbar = xcd_barrier_post(ctl + CW_BAR, (volatile LAS unsigned*)(lds + LDS_BARST));
#define NEXT_TICKET(dst) do { __syncthreads(); if (threadIdx.x == 0) *(volatile LAS unsigned*)(lds + LDS_BYTES - 32) = xb_add(ctl + CW_TICKET, 1u); __syncthreads(); dst = (int)*(volatile LAS unsigned*)(lds + LDS_BYTES - 32); } while (0)
#define NEXT_TICKET2(dst) do { __syncthreads(); if (threadIdx.x == 0) *(volatile LAS unsigned*)(lds + LDS_BYTES - 32) = xb_add(ctl + CW_TICKET2, 1u); __syncthreads(); dst = (int)*(volatile LAS unsigned*)(lds + LDS_BYTES - 32); } while (0)
#define SEAM(k) do { if (lo <= (k) && (k) + 1 < hi) xcd_barrier(gbar, wave); } while (0)
#ifndef PHMASK
#define PHMASK 0xFFFF
#endif
#ifndef REPEAT_PH
#define REPEAT_PH -1
#endif
#define REP(k) for (int rep_ = 0; rep_ < ((REPEAT_PH == (k)) ? 2 : 1); ++rep_)
#define IN(k) (((PHMASK >> (k)) & 1) && lo <= (k) && (k) < hi)

    if (IN(0)) REP(0) {
        PHASE_PTRS
        float tmp[16];
        for (int m = gw; m < T; m += NGW) rms_row(x + (size_t)m * D, AIN[1], XN + (size_t)m * D, lane, tmp);
#if MFMA_GEMM
        {
            LAS float* scr = (LAS float*)(lds + wave * 16384);
            constexpr int I_IN = 16 * (INC / 32), I_OUT = 16 * (D / 32);
            constexpr int I_L = 16 + 16 + 32;
            constexpr int NIT = I_IN + I_OUT + I_L;
            for (int it = gw; it < NIT; it += NGW) {
                int r = it;
                if (r < I_IN) { transpose_item(AIN[2], D, INC, WIN, scr, r, lane); continue; } r -= I_IN;
                if (r < I_OUT) { transpose_item(AIN[19], D, D, WOUT, scr, r, lane); continue; } r -= I_OUT;
                if (r < 16) { transpose_item(AIN[5], 64, RW, (bf16_t*)(ws + WS_WBT), scr, r, lane); continue; } r -= 16;
                if (r < 16) { transpose_item(AIN[7], 64, RW, (bf16_t*)(ws + WS_ABT), scr, r, lane); continue; } r -= 16;
                transpose_item(AIN[8], 128, RW, (bf16_t*)(ws + WS_GBT), scr, r, lane);
            }
            { const int gt = bid * NTHREADS + tid;
              if (gt < D * NE) { const int k = gt >> 5, e = gt & 31; const float w = AIN[20][k] * AIN[21][gt];
                  const unsigned short h0 = (unsigned short)f2bf(w); const float r1 = w - bf2f(h0); const unsigned short h1 = (unsigned short)f2bf(r1); const float r2 = r1 - bf2f(h1); const unsigned short h2 = (unsigned short)f2bf(r2);
                  bf16_t* rws = (bf16_t*)(ws + WS_RWS); rws[(size_t)(0 * NE + e) * D + k] = h0; rws[(size_t)(1 * NE + e) * D + k] = h1; rws[(size_t)(2 * NE + e) * D + k] = h2; } }
        }
#endif
    }
#if MFMA_GEMM
    auto gemm_ph = [&](auto phc) {
        constexpr int ph = decltype(phc)::value;
        PHASE_PTRS
        LAS int* meta = (LAS int*)(lds + 131072);
        if (ph >= 8) {
            __syncthreads();
            if (tid < 32) {
                const int cn = (int)xb_ld(&cnt[tid]); const int nt_ = (cn + 255) / 256; int incl = nt_;
#pragma unroll
                for (int d = 1; d < 32; d <<= 1) { const int o = __shfl_up(incl, d, 32); if (tid >= d) incl += o; }
                meta[tid] = incl - nt_; meta[64 + tid] = (incl - nt_) * 256; meta[128 + tid] = cn; if (tid == NE - 1) meta[NE] = incl; }
            __syncthreads();
        }
        if constexpr (ph == 1) { pg8::DenseOrder S; S.init(T, INC, G, bid); pg8::EpiProj E{PROJ}; pg8::gemm_phase<pg8::EpiProj, pg8::DenseOrder, pg8::RowDense, true, false>(lds, XN, WIN, S, pg8::RowDense{2048u}, E, wave, lane); }
        else if constexpr (ph == 6) { pg8::DenseOrder S; S.init(T, D, G, bid); pg8::EpiOut E{x, H1}; pg8::gemm_phase<pg8::EpiOut, pg8::DenseOrder, pg8::RowDense, true, false>(lds, Y, WOUT, S, pg8::RowDense{2048u}, E, wave, lane); }
        else if constexpr (ph == 8) { pg8::MoeOrder S{meta, 2 * DFF / 256, G, bid, meta[NE] * (2 * DFF / 256)}; pg8::EpiUp E{ACT, AIN[24], 1.f / 32.f};
            pg8::gemm_phase<pg8::EpiUp, pg8::MoeOrder, pg8::RowGather, true, true>(lds, XN, WUP, S, pg8::RowGather{ltok, 1024u}, E, wave, lane); }
        else { pg8::MoeOrder S{meta, D / 256, G, bid, meta[NE] * (D / 256)}; pg8::EpiDown E{YK, AIN[26], ldst, lgate, 1.f / 32.f};
            pg8::gemm_phase<pg8::EpiDown, pg8::MoeOrder, pg8::RowDense, true, true>(lds, ACT, WDN, S, pg8::RowDense{1024u}, E, wave, lane); }
    };
#else
    auto gemm_ph = [&](auto phc) {
        constexpr int ph = decltype(phc)::value;
        PHASE_PTRS
        LAS int* rowidx = (LAS int*)(lds + 2 * 16 * NG_LD * 4);
        LAS int* meta = rowidx + 128;
        const bool moe = ph >= 8;
        __syncthreads();
        if (moe && tid == 0) {
            int tp = 0, sb = 0;
            for (int e = 0; e < NE; ++e) { const int cn = (int)xb_ld(&cnt[e]); meta[e] = tp; meta[64 + e] = sb; meta[128 + e] = cn; tp += (cn + 127) / 128; sb += (cn + 255) / 256 * 256; }
            meta[NE] = tp;
        }
        __syncthreads();
        const int nrt = moe ? meta[NE] : T / 128;
        const int ncols = (ph == 1) ? INC : (ph == 8) ? 2 * DFF : D;
        const int nct = ncols / 128;
        const bf16_t* Ab = (ph == 1 || ph == 8) ? XN : (ph == 6) ? Y : ACT;
        for (int u = bid; u < nrt * nct; u += G) {
            const int rt = u / nct, ct = u % nct;
            int e = 0, r0 = rt * 128, cn = T, sb = 0;
            if (moe) { for (int q = 1; q < NE; ++q) if (meta[q] <= rt) e = q;
                       r0 = (rt - meta[e]) * 128; cn = meta[128 + e]; sb = meta[64 + e]; }
            __syncthreads();
            if (tid < 128) { const int r = r0 + tid; rowidx[tid] = (r < cn) ? (ph == 8 ? ltok[(size_t)e * T + r] : sb + r) : -1; }
            __syncthreads();
            const float* Wm = (ph == 1) ? AIN[2] : (ph == 6) ? AIN[19] : (ph == 8) ? AIN[23] + (size_t)e * D * 2 * DFF : AIN[25] + (size_t)e * DFF * D;
            const float* bias = (ph == 8) ? AIN[24] + (size_t)e * 2 * DFF : (ph == 9) ? AIN[26] + (size_t)e * D : nullptr;
            auto epi = [&](int r, int ri, int col, f32x4 v) {
                if (ri < 0) return;
                if (ph == 1) { u32x2 w; w.x = pk2(v.x, v.y); w.y = pk2(v.z, v.w); *(u32x2*)(PROJ + (size_t)ri * INC + col) = w; }
                else if (ph == 6) { const f32x4 xr = *(const f32x4*)(x + (size_t)ri * D + col); const f32x4 hv = xr + v; u32x2 w; w.x = pk2(hv.x, hv.y); w.y = pk2(hv.z, hv.w); *(u32x2*)(H1 + (size_t)ri * D + col) = w; }
                else if (ph == 8) {
                    const f32x4 bb = *(const f32x4*)(bias + col); v = v + bb;
                    const float g0 = fminf(v.x, 7.f), l0 = fminf(fmaxf(v.y, -7.f), 7.f), g1 = fminf(v.z, 7.f), l1 = fminf(fmaxf(v.w, -7.f), 7.f);
                    const float a0 = g0 * sigmoidf_(1.702f * g0) * (l0 + 1.f), a1 = g1 * sigmoidf_(1.702f * g1) * (l1 + 1.f);
                    *(unsigned*)(ACT + (size_t)(sb + r0 + r) * DFF + (col >> 1)) = pk2(a0, a1);
                } else {
                    const f32x4 bb = *(const f32x4*)(bias + col); const float gt = lgate[(size_t)e * T + r0 + r]; const int dst = ldst[(size_t)e * T + r0 + r];
                    v = (v + bb) * gt;
                    u32x2 w; w.x = pk2(v.x, v.y); w.y = pk2(v.z, v.w); *(u32x2*)(YK + (size_t)dst * D + col) = w;
                }
            };
            ngemm_unit(lds, Ab, 1024, Wm, ncols, ct * 128, epi);
        }
    };
#endif
    SEAM(0);
    if (IN(1) && (int)blockIdx.x >= (T / 256) * (INC / 256) - 6 * (int)gridDim.x && gridDim.x == 256) {
        PHASE_PTRS
        int cvt; NEXT_TICKET2(cvt);
        if (cvt < CV_TICKETS) convert_ticket(cvt, AIN[23], AIN[25], (unsigned char*)WUP, (unsigned char*)WDN, (LAS float*)(lds + wave * 16384), wave, lane);
        __syncthreads();
    }
    if (IN(1)) REP(1) gemm_ph(std::integral_constant<int, 1>{});
    SEAM(1);
    if (IN(2)) REP(2) {
        PHASE_PTRS
        typedef short bf16x8 __attribute__((ext_vector_type(8)));
        typedef float f32x16 __attribute__((ext_vector_type(16)));
        const float *mu = AIN[3], *w0 = AIN[4], *a0 = AIN[6], *kkw = AIN[9], *kaw = AIN[10], *rkw = AIN[11];
        const bf16_t *WBT = (const bf16_t*)(ws + WS_WBT), *ABT = (const bf16_t*)(ws + WS_ABT), *GBT = (const bf16_t*)(ws + WS_GBT);
        constexpr int TRS = 3600, LRS = 528, OFF_LO = 33 * TRS;
        const int r32 = lane & 31, hi = lane >> 5, h = wave;
        for (int it = bid; it < T / 32; it += G) {
            const int t0 = it * 32; const bool first = (t0 % SEQ) == 0;
            __syncthreads();
            {
                u32x4 sl[5];
#pragma unroll
                for (int rr_ = 0; rr_ < 5; ++rr_) { const int row = wave + 8 * rr_; sl[rr_] = (u32x4){0u, 0u, 0u, 0u};
                    if (row < 33 && lane < 32 && (row > 0 || !first)) sl[rr_] = *(const u32x4*)(PROJ + (size_t)(t0 - 1 + row) * INC + (192 + lane) * 8); }
#pragma unroll
                for (int rr_ = 0; rr_ < 5; ++rr_) { const int row = wave + 8 * rr_; if (row < 33 && lane < 32) *(LAS u32x4*)(lds + row * TRS + (192 + lane) * 16) = sl[rr_]; }
            }
            __syncthreads();
            u32x4 sv[5][3];
#pragma unroll
            for (int rr_ = 0; rr_ < 5; ++rr_) { const int row = wave + 8 * rr_;
#pragma unroll
                for (int q = 0; q < 3; ++q) { sv[rr_][q] = (u32x4){0u, 0u, 0u, 0u};
                    if (row < 33 && (row > 0 || !first)) sv[rr_][q] = *(const u32x4*)(PROJ + (size_t)(t0 - 1 + row) * INC + (lane + 64 * q) * 8); } }
#pragma unroll 4
            for (int q = 0; q < 16; ++q) {
                const int j = tid & 255, tok = (tid >> 8) + 2 * q, col = 1536 + j;
                const float cur = bf2f(*(const LAS unsigned short*)(lds + (tok + 1) * TRS + col * 2)), prv = bf2f(*(const LAS unsigned short*)(lds + tok * TRS + col * 2));
                const float p = cur + (prv - cur) * mu[col];
                float f = p;
                if (__builtin_amdgcn_readfirstlane(j) < 64) { const float e2 = __expf(-2.f * fabsf(p)); f = copysignf((1.f - e2) * __builtin_amdgcn_rcpf(1.f + e2), p); }
                else if (__builtin_amdgcn_readfirstlane(j) >= 128) f = __builtin_amdgcn_rcpf(1.f + __expf(-p));
                *(LAS unsigned short*)(lds + OFF_LO + tok * LRS + j * 2) = (unsigned short)f2bf(f);
            }
#pragma unroll
            for (int rr_ = 0; rr_ < 5; ++rr_) { const int row = wave + 8 * rr_;
#pragma unroll
                for (int q = 0; q < 3; ++q) if (row < 33) *(LAS u32x4*)(lds + row * TRS + (lane + 64 * q) * 16) = sv[rr_][q]; }
            __syncthreads();
            f32x16 Wa[2], Aa[2], Ga[2];
#pragma unroll
            for (int ct = 0; ct < 2; ++ct) {
                const int col = 64 * h + 32 * ct + r32;
#pragma unroll
                for (int r = 0; r < 16; ++r) { Wa[ct][r] = 0.f; Aa[ct][r] = 0.f; Ga[ct][r] = 0.f; }
#pragma unroll
                for (int s4 = 0; s4 < 4; ++s4) {
                    const bf16x8 aw = *(const LAS bf16x8*)(lds + OFF_LO + r32 * LRS + (16 * s4 + 8 * hi) * 2), aa = *(const LAS bf16x8*)(lds + OFF_LO + r32 * LRS + (64 + 16 * s4 + 8 * hi) * 2);
                    const bf16x8 bw = *(const bf16x8*)(WBT + (size_t)col * 64 + 16 * s4 + 8 * hi), ba = *(const bf16x8*)(ABT + (size_t)col * 64 + 16 * s4 + 8 * hi);
                    Wa[ct] = __builtin_amdgcn_mfma_f32_32x32x16_bf16(aw, bw, Wa[ct], 0, 0, 0);
                    Aa[ct] = __builtin_amdgcn_mfma_f32_32x32x16_bf16(aa, ba, Aa[ct], 0, 0, 0);
                }
#pragma unroll
                for (int s8 = 0; s8 < 8; ++s8) {
                    const bf16x8 ag = *(const LAS bf16x8*)(lds + OFF_LO + r32 * LRS + (128 + 16 * s8 + 8 * hi) * 2);
                    const bf16x8 bg = *(const bf16x8*)(GBT + (size_t)col * 128 + 16 * s8 + 8 * hi);
                    Ga[ct] = __builtin_amdgcn_mfma_f32_32x32x16_bf16(ag, bg, Ga[ct], 0, 0, 0);
                }
            }
            float cmu[2][3], cw0[2], ca0[2], ckk[2], cka[2], crk[2];
#pragma unroll
            for (int ct = 0; ct < 2; ++ct) { const int c = 64 * h + 32 * ct + r32;
                cmu[ct][0] = mu[c]; cmu[ct][1] = mu[512 + c]; cmu[ct][2] = mu[1024 + c]; cw0[ct] = w0[c]; ca0[ct] = a0[c]; ckk[ct] = kkw[c]; cka[ct] = kaw[c]; crk[ct] = rkw[c]; }
#pragma unroll
            for (int r = 0; r < 16; ++r) {
                const int i = (r & 3) + 8 * (r >> 2) + 4 * hi; const size_t t = (size_t)t0 + i;
                float rr[2], k2[2], vv[2], kkv[2], av[2], dec[2];
                float n2 = 0.f, rkd = 0.f;
#pragma unroll
                for (int ct = 0; ct < 2; ++ct) {
                    const int c = 64 * h + 32 * ct + r32;
                    const LAS unsigned char* pc = lds + (i + 1) * TRS + c * 2; const LAS unsigned char* pp = lds + i * TRS + c * 2;
                    const float rc = bf2f(*(const LAS unsigned short*)pc), kc = bf2f(*(const LAS unsigned short*)(pc + 1024)), vc = bf2f(*(const LAS unsigned short*)(pc + 2048));
                    const float rp = bf2f(*(const LAS unsigned short*)pp), kp = bf2f(*(const LAS unsigned short*)(pp + 1024)), vp = bf2f(*(const LAS unsigned short*)(pp + 2048));
                    rr[ct] = rc + (rp - rc) * cmu[ct][0]; const float k = kc + (kp - kc) * cmu[ct][1]; vv[ct] = vc + (vp - vc) * cmu[ct][2];
                    const float wraw = cw0[ct] + Wa[ct][r];
                    dec[ct] = -0.6065306597126334f * __builtin_amdgcn_rcpf(1.f + __expf(-wraw));
                    av[ct] = __builtin_amdgcn_rcpf(1.f + __expf(-(ca0[ct] + Aa[ct][r])));
                    kkv[ct] = k * ckk[ct]; n2 += kkv[ct] * kkv[ct];
                    k2[ct] = k * (1.f + (av[ct] - 1.f) * cka[ct]);
                    rkd += rr[ct] * k2[ct] * crk[ct];
                }
                n2 += dpp_f<0xB1>(n2); rkd += dpp_f<0xB1>(rkd); n2 += dpp_f<0x4E>(n2); rkd += dpp_f<0x4E>(rkd);
                n2 += dpp_f<0x141>(n2); rkd += dpp_f<0x141>(rkd); n2 += dpp_f<0x140>(n2); rkd += dpp_f<0x140>(rkd);
                n2 += __shfl_xor(n2, 16); rkd += __shfl_xor(rkd, 16);
                const float inorm = __builtin_amdgcn_rsqf(fmaxf(n2, 1e-24f));
#pragma unroll
                for (int ct = 0; ct < 2; ++ct) {
                    const size_t o = t * RW + 64 * h + 32 * ct + r32;
                    const float kkn = kkv[ct] * inorm;
                    u32x4 rec; rec.x = pk2(rr[ct], k2[ct]); rec.y = pk2(vv[ct], kkn); rec.z = pk2(kkn * av[ct], Ga[ct][r]); rec.w = pk2(dec[ct], 0.f);
                    *(u32x4*)(REC + o * 8) = rec;
                }
                if (r32 == 0) RKD[t * NRH + h] = rkd;
            }
        }
    }
    SEAM(2);
    int q_ticket = 0;
    if (IN(3)) REP(3) {
        PHASE_PTRS
        using namespace rk;
        const float *lng = AIN[12], *lnb = AIN[13];
        int r32 = lane & 31, hi = lane >> 5;
#define OPQ() asm volatile("" : "+v"(r32), "+v"(hi))
        const int sl = wave >> 2, wq = wave & 3;
        int slv = sl * SLOT; asm volatile("" : "+v"(slv));
        LAS unsigned char* const LS = lds + slv;
        for (;;) {
            NEXT_TICKET(q_ticket);
            if (q_ticket >= NB * NRH) break;
            const int item = q_ticket;
            const int b = item / NRH, h = item % NRH;
            const size_t tb = (size_t)b * SEQ;
            f32x16 Macc = zero16(), XT = zero16(), HA = zero16(), HB = zero16();
            __syncthreads();
            for (int i = tid; i < 9216 / 4; i += NTHREADS) ((LAS unsigned*)(lds + OFF_M0))[i] = 0u;
            const size_t cb = (size_t)h * 64 + lane;
            float pf_rkd[8]; u32x4 pf[8];
            auto prefetch = [&](size_t t0n) {
#pragma unroll
                for (int e = 0; e < 8; ++e) { const size_t t = t0n + (e >> 2) * 32 + 4 * wave + (e & 3);
                    pf[e] = *(const u32x4*)(REC + (t * RW + cb) * 8); pf_rkd[e] = RKD[t * NRH + h]; }
            };
            prefetch(tb);
            for (int cp = 0; cp < SEQ / 64; ++cp) {
                const size_t t0 = tb + (size_t)cp * 64;
                float lcum[8], lw[8];
#pragma unroll
                for (int s2 = 0; s2 < 2; ++s2) { float run = 0.f;
#pragma unroll
                  for (int e = 0; e < 4; ++e) { lw[4 * s2 + e] = bf2f(pf[4 * s2 + e].w & 0xffff); run += lw[4 * s2 + e]; lcum[4 * s2 + e] = run; }
                  ((LAS float*)(lds + s2 * SLOT + OFF_WT))[wave * 64 + lane] = run; }
                __syncthreads();
                unsigned cur_vg[8]; float cur_rkd[8];
#pragma unroll
                for (int s2 = 0; s2 < 2; ++s2) {
                    LAS unsigned char* L = lds + s2 * SLOT;
                    float base = 0.f, tot = 0.f;
#pragma unroll
                    for (int w2 = 0; w2 < 8; ++w2) { const float x = ((const LAS float*)(L + OFF_WT))[w2 * 64 + lane]; if (w2 < wave) base += x; tot += x; }
                    float kkd[4], rd[4], bi[4], ki[4];
#pragma unroll
                    for (int e = 0; e < 4; ++e) { const int q = 4 * s2 + e;
                        const float Lc = base + lcum[q];
                        const float gm1 = __expf(Lc - lw[q]), g = __expf(Lc), gi = __expf(-Lc);
                        kkd[e] = bf2f(pf[q].y >> 16) * gm1; rd[e] = bf2f(pf[q].x & 0xffff) * g; bi[e] = bf2f(pf[q].z & 0xffff) * gi; ki[e] = bf2f(pf[q].x >> 16) * gi;
                        cur_vg[q] = (pf[q].y & 0xffff) | (pf[q].z & 0xffff0000u); cur_rkd[q] = pf_rkd[q]; }
                    asm volatile("" ::: "memory");
                    {
#pragma unroll
                      for (int e = 0; e < 4; ++e) { const int ro = (4 * wave + e) * RS64 + 2 * lane;
                        *(LAS unsigned short*)(L + OFF_KKD + ro) = (unsigned short)(hpk(kkd[e], 0.f)); *(LAS unsigned short*)(L + OFF_RD + ro) = (unsigned short)(hpk(rd[e], 0.f));
                        *(LAS unsigned short*)(L + OFF_BI + ro) = (unsigned short)(hpk(bi[e], 0.f)); *(LAS unsigned short*)(L + OFF_KI + ro) = (unsigned short)(hpk(ki[e], 0.f)); } }
                    const int to = lane * RS32 + 8 * wave;
                    { u32x2 w; w.x = hpk(kkd[0], kkd[1]); w.y = hpk(kkd[2], kkd[3]); *(LAS u32x2*)(L + OFF_KKDT + to) = w; }
                    { u32x2 w; w.x = hpk(bi[0], bi[1]); w.y = hpk(bi[2], bi[3]); *(LAS u32x2*)(L + OFF_BIT + to) = w; }
                    { u32x2 w; w.x = hpk(ki[0], ki[1]); w.y = hpk(ki[2], ki[3]); *(LAS u32x2*)(L + OFF_KIT + to) = w; }
                    { u32x2 w; w.x = (pf[4 * s2].y & 0xffff) | (pf[4 * s2 + 1].y << 16); w.y = (pf[4 * s2 + 2].y & 0xffff) | (pf[4 * s2 + 3].y << 16); *(LAS u32x2*)(L + OFF_VT + to) = w; }
                    if (wave == 7) ((LAS float*)(L + OFF_GAM))[lane] = __expf(tot);
                }
                if (cp + 1 < SEQ / 64) prefetch(t0 + 64);
                __syncthreads(); OPQ();
                if (wq == 0) {
                    f32x16 a = zero16(); mm<4, false>(a, LS + OFF_KKD, RS64, 0, LS + OFF_BI, RS64, 0, r32, hi);
#pragma unroll
                    for (int r = 0; r < 16; ++r) { const int row = (r & 3) + 8 * (r >> 2) + 4 * hi; a[r] = (r32 < row) ? -a[r] : 0.f; }
                    tstore(a, LS + OFF_PT0, RS32, 0, 0, r32, hi);
                } else if (wq == 1) {
                    f32x16 a = zero16(); mm<4, false>(a, LS + OFF_BI, RS64, 0, LS + OFF_KKD, RS64, 0, r32, hi);
#pragma unroll
                    for (int r = 0; r < 16; ++r) { const int row = (r & 3) + 8 * (r >> 2) + 4 * hi; a[r] = (row < r32) ? -a[r] : 0.f; }
                    tstore(a, LS + OFF_P0, RS32, 0, 0, r32, hi);
#pragma unroll
                    for (int r = 0; r < 16; ++r) { const int row = (r & 3) + 8 * (r >> 2) + 4 * hi; XT[r] = a[r] + ((row == r32) ? 1.f : 0.f); }
                    tstore(XT, LS + OFF_X0, RS32, 0, 0, r32, hi);
                } else if (wq == 2) {
                    f32x16 a = zero16(); mm<4, false>(a, LS + OFF_KI, RS64, 0, LS + OFF_KKD, RS64, 0, r32, hi);
#pragma unroll
                    for (int r = 0; r < 16; ++r) { const int row = (r & 3) + 8 * (r >> 2) + 4 * hi; a[r] = (row < r32) ? a[r] : 0.f; }
                    tstore(a, LS + OFF_AK, RS32, 0, 0, r32, hi);
                } else {
                    f32x16 a = zero16(); mm<4, false>(a, LS + OFF_BI, RS64, 0, LS + OFF_RD, RS64, 0, r32, hi);
#pragma unroll
                    for (int r = 0; r < 16; ++r) { const int row = (r & 3) + 8 * (r >> 2) + 4 * hi; a[r] = (row <= r32) ? a[r] : 0.f; }
                    tstore(a, LS + OFF_BRB, RS32, 0, 0, r32, hi);
                }
                __syncthreads(); OPQ();
                if (wq == 0) { f32x16 a = zero16(); mm<2, false>(a, LS + OFF_P0, RS32, 0, LS + OFF_PT0, RS32, 0, r32, hi); tstore(a, LS + OFF_PT1, RS32, 0, 0, r32, hi); }
                else if (wq == 2) { f32x16 a = zero16(); mm<2, false>(a, LS + OFF_PT0, RS32, 0, LS + OFF_P0, RS32, 0, r32, hi); tstore(a, LS + OFF_P1, RS32, 0, 0, r32, hi); }
                else { const int vh = wq >> 1; f32x16 a = zero16(); mm<2, false>(a, LS + OFF_AK, RS32, 0, LS + OFF_VT, RS32, 32 * vh, r32, hi); tstore(a, LS + OFF_AKVT, RS32, 32 * vh, 0, r32, hi); }
                __syncthreads(); OPQ();
                if (wq == 0) { f32x16 a = zero16(); mm<2, false>(a, LS + OFF_P1, RS32, 0, LS + OFF_PT1, RS32, 0, r32, hi); tstore(a, LS + OFF_PT0, RS32, 0, 0, r32, hi); }
                else if (wq == 2) { f32x16 a = zero16(); mm<2, false>(a, LS + OFF_PT1, RS32, 0, LS + OFF_P1, RS32, 0, r32, hi); tstore(a, LS + OFF_P0, RS32, 0, 0, r32, hi); }
                else if (wq == 1) { mm<2, false>(XT, LS + OFF_PT1, RS32, 0, LS + OFF_X0, RS32, 0, r32, hi); tstore(XT, LS + OFF_X1, RS32, 0, 0, r32, hi); }
                __syncthreads(); OPQ();
                if (wq == 0) { f32x16 a = zero16(); mm<2, false>(a, LS + OFF_P0, RS32, 0, LS + OFF_PT0, RS32, 0, r32, hi); tstore(a, LS + OFF_PT1, RS32, 0, 0, r32, hi); }
                else if (wq == 2) { f32x16 a = zero16(); mm<2, false>(a, LS + OFF_PT0, RS32, 0, LS + OFF_P0, RS32, 0, r32, hi); tstore(a, LS + OFF_P1, RS32, 0, 0, r32, hi); }
                else if (wq == 1) { mm<2, false>(XT, LS + OFF_PT0, RS32, 0, LS + OFF_X1, RS32, 0, r32, hi); tstore(XT, LS + OFF_X0, RS32, 0, 0, r32, hi); }
                __syncthreads(); OPQ();
                if (wq == 0) { f32x16 a = zero16(); mm<2, false>(a, LS + OFF_P1, RS32, 0, LS + OFF_PT1, RS32, 0, r32, hi); tstore(a, LS + OFF_PT0, RS32, 0, 0, r32, hi); }
                else if (wq == 1) { mm<2, false>(XT, LS + OFF_PT1, RS32, 0, LS + OFF_X0, RS32, 0, r32, hi); tstore(XT, LS + OFF_X1, RS32, 0, 0, r32, hi); }
                else if (wq == 3) { f32x16 a = zero16(); mm<4, false>(a, LS + OFF_KI, RS64, 0, LS + OFF_RD, RS64, 0, r32, hi);
#pragma unroll
                    for (int r = 0; r < 16; ++r) { const int row = (r & 3) + 8 * (r >> 2) + 4 * hi; a[r] = (row <= r32) ? a[r] : 0.f; }
                    tstore(a, LS + OFF_BRK, RS32, 0, 0, r32, hi); }
                __syncthreads(); OPQ();
                if (wq == 1) { mm<2, false>(XT, LS + OFF_PT0, RS32, 0, LS + OFF_X1, RS32, 0, r32, hi); tstore(XT, LS + OFF_X0, RS32, 0, 0, r32, hi); }
                __syncthreads(); OPQ();
                if (wq < 2) { f32x16 a = zero16(); mm<2, false>(a, LS + OFF_X0, RS32, 0, LS + OFF_KKDT, RS32, 32 * wq, r32, hi); tstore(a, LS + OFF_P1T, RS32, 32 * wq, 0, r32, hi); }
                else { const int vh = wq - 2; f32x16 a = zero16(); mm<2, false>(a, LS + OFF_X0, RS32, 0, LS + OFF_AKVT, RS32, 32 * vh, r32, hi); tstore(a, LS + OFF_P2T, RS32, 32 * vh, 0, r32, hi); }
                __syncthreads(); OPQ();
#pragma unroll
                for (int s2 = 0; s2 < 2; ++s2) {
                    OPQ();
                    LAS unsigned char* L = lds + s2 * SLOT;
                    f32x16& HX = s2 ? HB : HA;
                    if (wave < 4) {
                        const int kh = wave >> 1, vh = wave & 1;
                        HX = zero16();
                        mm<2, false>(HX, L + OFF_KIT, RS32, 32 * kh, L + OFF_VT, RS32, 32 * vh, r32, hi);
                        mm<2, true>(HX, L + OFF_BIT, RS32, 32 * kh, L + OFF_P2T, RS32, 32 * vh, r32, hi);
                        f32x16 a = zero16(); mm<2, false>(a, L + OFF_P1T, RS32, 32 * kh, L + OFF_BIT, RS32, 32 * vh, r32, hi);
                        const float gmc = -((const LAS float*)(L + OFF_GAM))[32 * vh + r32];
#pragma unroll
                        for (int r = 0; r < 16; ++r) a[r] *= gmc;
                        tstore(a, L + OFF_G, RS64, 32 * vh, 32 * kh, r32, hi);
                    } else if (wave < 6) {
                        const int vh = wave - 4;
                        HX = zero16();
                        mm<2, false>(HX, L + OFF_BRK, RS32, 0, L + OFF_VT, RS32, 32 * vh, r32, hi);
                        mm<2, true>(HX, L + OFF_BRB, RS32, 0, L + OFF_P2T, RS32, 32 * vh, r32, hi);
                    } else {
                        const int kh = wave - 6;
                        f32x16 a = zero16(); mm<2, false>(a, L + OFF_P1T, RS32, 32 * kh, L + OFF_BRB, RS32, 0, r32, hi);
                        f32x16 q; tload(q, L + OFF_RD, RS64, 0, 32 * kh, r32, hi);
#pragma unroll
                        for (int r = 0; r < 16; ++r) q[r] -= a[r];
                        tstore(q, L + OFF_Q1, RS64, 0, 32 * kh, r32, hi);
                    }
                }
                __syncthreads(); OPQ();
#pragma unroll
                for (int s2 = 0; s2 < 2; ++s2) {
                    LAS unsigned char* L = lds + s2 * SLOT;
                    LAS unsigned char* Mold = lds + (s2 ? OFF_M1 : OFF_M0); LAS unsigned char* Mnew = lds + (s2 ? OFF_M0 : OFF_M1);
                    f32x16& HX = s2 ? HB : HA;
                    if (wave < 4) {
                        const int kh = wave >> 1, vh = wave & 1;
                        const LAS float* gam = (const LAS float*)(L + OFF_GAM);
#pragma unroll
                        for (int r = 0; r < 16; ++r) Macc[r] = gam[32 * kh + (r & 3) + 8 * (r >> 2) + 4 * hi] * (Macc[r] + HX[r]);
                        mm<4, false>(Macc, L + OFF_G, RS64, 32 * kh, Mold, RS64, 32 * vh, r32, hi);
                        tstore(Macc, Mnew, RS64, 32 * vh, 32 * kh, r32, hi);
                    } else if (wave < 6) {
                        const int vh = wave - 4;
                        mm<4, false>(HX, L + OFF_Q1, RS64, 0, Mold, RS64, 32 * vh, r32, hi);
                        LAS float* yb = (LAS float*)(L + OFF_YB);
#pragma unroll
                        for (int r = 0; r < 16; ++r) yb[((r & 3) + 8 * (r >> 2) + 4 * hi) * 64 + 32 * vh + r32] = HX[r];
                    }
                    __syncthreads(); OPQ();
                }
                {
                    const int cc = h * 64 + lane;
                    const float g_ln = lng[cc], b_ln = lnb[cc];
#pragma unroll
                    for (int q = 0; q < 8; ++q) {
                        const int i = 4 * wave + (q & 3); const size_t t = t0 + (q >> 2) * 32 + i;
                        const float y = ((const LAS float*)(lds + (q >> 2) * SLOT + OFF_YB))[i * 64 + lane];
                        const float mean = wave_sum(y) * (1.f / 64.f); const float d = y - mean;
                        const float var = wave_sum(d * d) * (1.f / 64.f);
                        float yn = d * rsqrtf(var + 64e-5f) * g_ln + b_ln;
                        yn += cur_rkd[q] * bf2f(cur_vg[q] & 0xffff);
                        yn *= bf2f(cur_vg[q] >> 16);
                        Y[t * D + cc] = (bf16_t)f2bf(yn);
                    }
                }
                __syncthreads();
            }
        }
    }
#undef OPQ
    if (IN(4)) {
        PHASE_PTRS
        if (!IN(3)) NEXT_TICKET(q_ticket);
        LAS float* scr = (LAS float*)(lds + wave * 16384);
        int cvt; NEXT_TICKET2(cvt);
        while (cvt < CV_TICKETS) { convert_ticket(cvt, AIN[23], AIN[25], (unsigned char*)WUP, (unsigned char*)WDN, scr, wave, lane); NEXT_TICKET2(cvt); }
    }
    if (IN(4)) REP(4) {
        PHASE_PTRS
        typedef short bf16x8 __attribute__((ext_vector_type(8)));
        typedef float f32x16 __attribute__((ext_vector_type(16)));
        typedef short s16x4 __attribute__((ext_vector_type(4)));
        constexpr int KBUF = 64 * 128, VBUF = 64 * 256;
        LAS unsigned char* Kb = lds; LAS unsigned char* Vb = lds + 6 * KBUF; LAS unsigned* stash = (LAS unsigned*)(lds + 6 * KBUF + 6 * VBUF);
        const float l1 = wave_sum(AIN[14][lane] * AIN[15][lane]), l2 = wave_sum(AIN[16][lane] * AIN[17][lane]);
        const float lam = __expf(l1) - __expf(l2) + 0.2f;
        const float* sg = AIN[18];
        for (; q_ticket < NB * NRH + NB * NDH * 8; ) {
            { const int idx = q_ticket - NB * NRH; const int qb = 7 - (idx >> 6), b = (idx & 63) >> 2, h = idx & 3;
            const float slope2 = exp2f(-8.f * (h + 1) / 4.f) * 1.4426950408889634f;
            {
                const int q0 = qb * 256, qw = q0 + 32 * wave;
                const int NT = 4 * (qb + 1);
                f32x16 o[4];
                for (int c = 0; c < 2; ++c) {
                    int tid_o = tid; asm volatile("" : "+v"(tid_o));
                    const int tid = tid_o, lane = tid & 63, r32 = lane & 31, hi = lane >> 5;
                    const int qpos = qw + r32;
                    const int ksw = (r32 >> 1) & 7, q4 = (lane & 15) >> 2;
                    const int vof0 = (4 * hi + q4) * 256 + (16 * ((lane >> 4) & 1) + 4 * (lane & 3)) * 2;
                    bf16x8 qf[4];
                    { const bf16_t* qp = PROJ + ((size_t)b * SEQ + qpos) * INC + RCOLS + h * 128 + c * 64 + hi * 8;
#pragma unroll
                      for (int s4 = 0; s4 < 4; ++s4) { const u32x4 raw = *(const u32x4*)(qp + s4 * 16); u32x4 w;
                          const float C2 = 0.125f * 1.4426950408889634f;
                          w.x = pk2(bf2f(raw.x & 0xffff) * C2, bf2f(raw.x >> 16) * C2); w.y = pk2(bf2f(raw.y & 0xffff) * C2, bf2f(raw.y >> 16) * C2);
                          w.z = pk2(bf2f(raw.z & 0xffff) * C2, bf2f(raw.z >> 16) * C2); w.w = pk2(bf2f(raw.w & 0xffff) * C2, bf2f(raw.w >> 16) * C2);
                          qf[s4] = __builtin_bit_cast(bf16x8, w); } }
#pragma unroll
                    for (int dt = 0; dt < 4; ++dt)
#pragma unroll
                        for (int r = 0; r < 16; ++r) o[dt][r] = 0.f;
                    float m = -1e30f, lsum = 0.f;
                    const int krow = 8 * wave + (lane >> 3), kch = (lane & 7) ^ ((krow >> 1) & 7);
                    const unsigned kgo = (unsigned)((b * SEQ + krow) * INC + RCOLS + 512 + h * 128 + c * 64 + kch * 8);
                    const int vrow0 = 4 * wave + (lane >> 4), vc16 = ((((lane & 15) >> 2) ^ (vrow0 & 3)) << 2) | (lane & 3);
                    const unsigned vgo = (unsigned)((b * SEQ + vrow0) * INC + RCOLS + 1024 + h * 128 + vc16 * 8);
#define ATT_ISSUE(tile) do { const unsigned go_ = (unsigned)(tile) * 64u * INC; const int sl_ = (tile) % 6; \
        __builtin_amdgcn_global_load_lds((const unsigned*)(PROJ + kgo + go_), (LAS unsigned*)(Kb + sl_ * KBUF + wave * 1024), 16, 0, 0); \
        __builtin_amdgcn_global_load_lds((const unsigned*)(PROJ + vgo + go_), (LAS unsigned*)(Vb + sl_ * VBUF + wave * 1024), 16, 0, 0); \
        __builtin_amdgcn_global_load_lds((const unsigned*)(PROJ + vgo + go_ + 32u * INC), (LAS unsigned*)(Vb + sl_ * VBUF + (wave + 8) * 1024), 16, 0, 0); } while (0)
                    __syncthreads();
                    ATT_ISSUE(0); ATT_ISSUE(1); ATT_ISSUE(2); ATT_ISSUE(3);
                    for (int stp = 0; stp < NT / 2; ++stp) {
                        if (stp + 1 < NT / 2) asm volatile("s_waitcnt vmcnt(6)" ::: "memory"); else asm volatile("s_waitcnt vmcnt(0)" ::: "memory");
                        __builtin_amdgcn_s_barrier();
                        asm volatile("" ::: "memory");
                        if (stp + 2 < NT / 2) { ATT_ISSUE(2 * stp + 4); ATT_ISSUE(2 * stp + 5); }
                      for (int sub = 0; sub < 2; ++sub) {
                        const int tt = 2 * stp + sub, rs3 = tt % 6;
                        if (tt * 64 > qw + 31) continue;
                        const LAS unsigned char* kb = Kb + rs3 * KBUF;
                        f32x16 p0, p1;
#pragma unroll
                        for (int r = 0; r < 16; ++r) { p0[r] = 0.f; p1[r] = 0.f; }
#pragma unroll
                        for (int s4 = 0; s4 < 4; ++s4) {
                            const int ko = r32 * 128 + (((2 * s4 + hi) ^ ksw) * 16); const bf16x8 k0 = *(const LAS bf16x8*)(kb + ko), k1 = *(const LAS bf16x8*)(kb + ko + 32 * 128);
                            p0 = __builtin_amdgcn_mfma_f32_32x32x16_bf16(k0, qf[s4], p0, 0, 0, 0);
                            p1 = __builtin_amdgcn_mfma_f32_32x32x16_bf16(k1, qf[s4], p1, 0, 0, 0);
                        }
                        const float tbias = slope2 * (float)(tt * 64 + 4 * hi - q0);
                        const bool band = (tt * 64 + 63 > qw);
                        float mx0 = -INFINITY, mx1 = -INFINITY;
#pragma unroll
                        for (int r = 0; r < 16; ++r) {
                            const float br = tbias + slope2 * (float)((r & 3) + 8 * (r >> 2));
                            p0[r] += br; p1[r] += br + 32.f * slope2;
                        }
                        if (__builtin_amdgcn_readfirstlane((int)band)) {
                            asm volatile("; causal band tile" ::: "memory");
                            const int kb0 = tt * 64 + 4 * hi;
#pragma unroll
                            for (int r = 0; r < 16; ++r) { const int kp = kb0 + (r & 3) + 8 * (r >> 2); if (kp > qpos) p0[r] = -INFINITY; if (kp + 32 > qpos) p1[r] = -INFINITY; }
                            asm volatile("" : "+v"(p0), "+v"(p1));
                        }
#pragma unroll
                        for (int r = 0; r < 16; r += 2) { mx0 = __builtin_fmaxf(__builtin_fmaxf(mx0, p0[r]), p0[r + 1]); mx1 = __builtin_fmaxf(__builtin_fmaxf(mx1, p1[r]), p1[r + 1]); }
                        float mx = __builtin_fmaxf(mx0, mx1);
                        { auto sw = __builtin_amdgcn_permlane32_swap(__float_as_uint(mx), __float_as_uint(mx), false, false); mx = __builtin_fmaxf(__uint_as_float(sw[0]), __uint_as_float(sw[1])); }
                        const float mn = __builtin_fmaxf(m, mx);
                        if (__any(mn > m)) {
                            const float sc = __builtin_amdgcn_exp2f(m - mn); lsum *= sc;
#pragma unroll
                            for (int dt = 0; dt < 4; ++dt)
#pragma unroll
                                for (int r = 0; r < 16; ++r) o[dt][r] *= sc;
                            m = mn;
                        }
                        float ps0 = 0.f, ps1 = 0.f;
#pragma unroll
                        for (int r = 0; r < 16; ++r) { p0[r] = __builtin_amdgcn_exp2f(p0[r] - m); p1[r] = __builtin_amdgcn_exp2f(p1[r] - m); ps0 += p0[r]; ps1 += p1[r]; }
                        lsum += ps0 + ps1;
                        bf16x8 pb[4];
#pragma unroll
                        for (int ks = 0; ks < 4; ++ks) { u32x4 w;
                            if (ks < 2) { const int r8 = 8 * ks; w.x = pk2(p0[r8], p0[r8 + 1]); w.y = pk2(p0[r8 + 2], p0[r8 + 3]); w.z = pk2(p0[r8 + 4], p0[r8 + 5]); w.w = pk2(p0[r8 + 6], p0[r8 + 7]); }
                            else { const int r8 = 8 * (ks - 2); w.x = pk2(p1[r8], p1[r8 + 1]); w.y = pk2(p1[r8 + 2], p1[r8 + 3]); w.z = pk2(p1[r8 + 4], p1[r8 + 5]); w.w = pk2(p1[r8 + 6], p1[r8 + 7]); }
                            pb[ks] = __builtin_bit_cast(bf16x8, w); }
                        const unsigned vbase = (unsigned)(uintptr_t)(Vb + rs3 * VBUF);
#pragma unroll
                        for (int dt = 0; dt < 4; ++dt) {
                            const unsigned va = vbase + (unsigned)(vof0 + ((dt ^ q4) * 64));
                            s16x4 f0[4], f1[4];
#pragma unroll
                            for (int ks = 0; ks < 4; ++ks) {
                                asm volatile("ds_read_b64_tr_b16 %0, %1 offset:%c2" : "=&v"(f0[ks]) : "v"(va), "i"(ks * 4096) : "memory");
                                asm volatile("ds_read_b64_tr_b16 %0, %1 offset:%c2" : "=&v"(f1[ks]) : "v"(va), "i"(ks * 4096 + 2048) : "memory");
                            }
                            asm volatile("s_waitcnt lgkmcnt(0)" ::: "memory"); __builtin_amdgcn_sched_barrier(0);
#pragma unroll
                            for (int ks = 0; ks < 4; ++ks) {
                                const bf16x8 av = {f0[ks][0], f0[ks][1], f0[ks][2], f0[ks][3], f1[ks][0], f1[ks][1], f1[ks][2], f1[ks][3]};
                                o[dt] = __builtin_amdgcn_mfma_f32_32x32x16_bf16(av, pb[ks], o[dt], 0, 0, 0);
                            }
                        }
                      }
                    }
                    lsum += __shfl_xor(lsum, 32);
                    const float il = 1.f / lsum;
                    u32x4* stq = (u32x4*)OC + (size_t)bid * 8 * NTHREADS + tid;
                    if (c == 0) {
#pragma unroll
                        for (int dt = 0; dt < 4; ++dt)
#pragma unroll
                            for (int rg = 0; rg < 2; ++rg) { u32x4 w; const int r = 8 * rg;
                                w.x = pk2(o[dt][r] * il, o[dt][r + 1] * il); w.y = pk2(o[dt][r + 2] * il, o[dt][r + 3] * il); w.z = pk2(o[dt][r + 4] * il, o[dt][r + 5] * il); w.w = pk2(o[dt][r + 6] * il, o[dt][r + 7] * il);
                                stq[(dt * 2 + rg) * NTHREADS] = w; }
                    } else {
                        float ss = 0.f;
#pragma unroll
                        for (int dt = 0; dt < 4; ++dt)
#pragma unroll
                            for (int rg = 0; rg < 2; ++rg) { const u32x4 w4 = stq[(dt * 2 + rg) * NTHREADS];
#pragma unroll
                                for (int j = 0; j < 4; ++j) { const int r = 8 * rg + 2 * j; const unsigned w = j == 0 ? w4.x : j == 1 ? w4.y : j == 2 ? w4.z : w4.w;
                                const float d0 = bf2f(w & 0xffff) - lam * o[dt][r] * il, d1 = bf2f(w >> 16) - lam * o[dt][r + 1] * il;
                                o[dt][r] = d0; o[dt][r + 1] = d1; ss += d0 * d0 + d1 * d1; } }
                        ss += __shfl_xor(ss, 32);
                        const float inv = rsqrtf(ss * (1.f / 128.f) + 1e-5f) * 0.8f;
                        bf16_t* yp = Y + ((size_t)b * SEQ + qpos) * D + 512 + h * 128 + 8 * hi;
#pragma unroll
                        for (int dt = 0; dt < 4; ++dt)
#pragma unroll
                            for (int p = 0; p < 2; ++p) { unsigned wv[2][2];
#pragma unroll
                                for (int q = 0; q < 2; ++q) { const int rg = 2 * p + q, d0 = dt * 32 + rg * 8; const f32x4 gg = *(const f32x4*)(sg + d0 + 4 * hi);
                                    wv[q][0] = pk2(o[dt][4 * rg] * inv * gg.x, o[dt][4 * rg + 1] * inv * gg.y); wv[q][1] = pk2(o[dt][4 * rg + 2] * inv * gg.z, o[dt][4 * rg + 3] * inv * gg.w); }
                                const auto s0 = __builtin_amdgcn_permlane32_swap(wv[0][0], wv[1][0], false, false); const auto s1 = __builtin_amdgcn_permlane32_swap(wv[0][1], wv[1][1], false, false);
                                u32x4 w; w.x = s0[0]; w.y = s1[0]; w.z = s0[1]; w.w = s1[1];
                                *(u32x4*)(yp + dt * 32 + 16 * p) = w; }
                    }
                }
            }
            }
            NEXT_TICKET(q_ticket);
        }
    }
#undef ATT_ISSUE
    SEAM(5);
    if (IN(6)) REP(6) gemm_ph(std::integral_constant<int, 6>{});
    SEAM(6);
    if (IN(7)) REP(7) {
        PHASE_PTRS
        typedef float f32x16 __attribute__((ext_vector_type(16)));
        const float *g2 = AIN[20], *rw = AIN[21], *rb = AIN[22];
        typedef short bf16x8 __attribute__((ext_vector_type(8)));
        LAS float* part = (LAS float*)lds;
        LAS float* psq = (LAS float*)(lds + 8 * 128 * 33 * 4);
        LAS float* invs = psq + 8 * 128;
        LAS unsigned* lcnt = (LAS unsigned*)(invs + 128);
        const int r32 = lane & 31, hi = lane >> 5;
        const bf16_t* rws = (const bf16_t*)(ws + WS_RWS);
        for (int unit = bid; unit < T / 128; unit += G) {
            const int tb0 = unit * 128;
            __syncthreads();
            if (tid < 32) lcnt[tid] = 0u;
            bf16x8 bw[8][3];
#pragma unroll
            for (int j = 0; j < 8; ++j)
#pragma unroll
                for (int im = 0; im < 3; ++im) bw[j][im] = *(const bf16x8*)(rws + (size_t)(im * NE + r32) * D + 128 * wave + 16 * j + 8 * hi);
            const bf16_t* xp = H1 + (size_t)(tb0 + r32) * D + 128 * wave + 8 * hi;
            bf16x8 xa[2][8];
#pragma unroll
            for (int j = 0; j < 8; ++j) xa[0][j] = *(const bf16x8*)(xp + 16 * j);
#pragma unroll
            for (int g = 0; g < 4; ++g) {
                if (g + 1 < 4) {
#pragma unroll
                    for (int j = 0; j < 8; ++j) xa[(g + 1) & 1][j] = *(const bf16x8*)(xp + (size_t)(32 * (g + 1)) * D + 16 * j); }
                f32x16 acc;
#pragma unroll
                for (int r = 0; r < 16; ++r) acc[r] = 0.f;
                float ssq = 0.f;
#pragma unroll
                for (int j = 0; j < 8; ++j) { const bf16x8 xr = xa[g & 1][j];
                    acc = __builtin_amdgcn_mfma_f32_32x32x16_bf16(xr, bw[j][0], acc, 0, 0, 0);
                    acc = __builtin_amdgcn_mfma_f32_32x32x16_bf16(xr, bw[j][1], acc, 0, 0, 0);
                    acc = __builtin_amdgcn_mfma_f32_32x32x16_bf16(xr, bw[j][2], acc, 0, 0, 0);
                    const u32x4 xw = __builtin_bit_cast(u32x4, xr);
                    const float x0 = bf2f(xw.x & 0xffff), x1 = bf2f(xw.x >> 16), x2 = bf2f(xw.y & 0xffff), x3 = bf2f(xw.y >> 16), x4 = bf2f(xw.z & 0xffff), x5 = bf2f(xw.z >> 16), x6 = bf2f(xw.w & 0xffff), x7 = bf2f(xw.w >> 16);
                    ssq += x0 * x0 + x1 * x1 + x2 * x2 + x3 * x3 + x4 * x4 + x5 * x5 + x6 * x6 + x7 * x7; }
                ssq += __shfl_xor(ssq, 32);
                if (hi == 0) psq[wave * 128 + 32 * g + r32] = ssq;
                LAS float* pg = part + (size_t)(wave * 128 + 32 * g) * 33;
#pragma unroll
                for (int r = 0; r < 16; ++r) pg[((r & 3) + 8 * (r >> 2) + 4 * hi) * 33 + r32] = acc[r];
            }
            __syncthreads();
            for (int idx = tid; idx < 128 * 32; idx += NTHREADS) { const int o = (idx >> 5) * 33 + (idx & 31); float sum = part[o];
#pragma unroll
                for (int w = 1; w < 8; ++w) sum += part[w * 128 * 33 + o];
                part[o] = sum; }
            if (tid < 128) { float q = psq[tid];
#pragma unroll
                for (int w = 1; w < 8; ++w) q += psq[w * 128 + tid];
                invs[tid] = rsqrtf(q * (1.f / D) + 1e-5f); }
            LAS float* lg = part + wave * (32 * 33);
            __syncthreads();
            int sel_e[4] = {0, 0, 0, 0}; unsigned sel_p[4] = {0u, 0u, 0u, 0u}; float sel_g[4] = {0.f, 0.f, 0.f, 0.f};
            const bool picker = (wave < 4) && (lane < 32);
            if (picker) {
                const float inv = invs[wave * 32 + lane];
                float v[32];
#pragma unroll
                for (int e = 0; e < 32; ++e) v[e] = lg[lane * 33 + e] * inv + rb[e];
                unsigned taken = 0u; float tv[4];
#pragma unroll
                for (int k = 0; k < 4; ++k) {
                    float best = -INFINITY; int be = 0;
#pragma unroll
                    for (int e = 0; e < 32; ++e) { const bool ok = !((taken >> e) & 1u) && (v[e] > best); best = ok ? v[e] : best; be = ok ? e : be; }
                    taken |= 1u << be; tv[k] = best; sel_e[k] = be;
                }
                const float e1 = __expf(tv[1] - tv[0]), e2 = __expf(tv[2] - tv[0]), e3 = __expf(tv[3] - tv[0]);
                const float isum = 1.f / (1.f + e1 + e2 + e3);
                sel_g[0] = isum; sel_g[1] = e1 * isum; sel_g[2] = e2 * isum; sel_g[3] = e3 * isum;
#pragma unroll
                for (int k = 0; k < 4; ++k) sel_p[k] = __hip_atomic_fetch_add(&lcnt[sel_e[k]], 1u, __ATOMIC_RELAXED, __HIP_MEMORY_SCOPE_WORKGROUP);
            }
            __syncthreads();
            if (tid < 32) lcnt[32 + tid] = atomicAdd(&cnt[tid], lcnt[tid]);
            __syncthreads();
            if (picker) {
                const int t = tb0 + wave * 32 + lane;
#pragma unroll
                for (int k = 0; k < 4; ++k) { const size_t li = (size_t)sel_e[k] * T + lcnt[32 + sel_e[k]] + sel_p[k];
                    ltok[li] = t; ldst[li] = t * TOPK + k; lgate[li] = sel_g[k]; }
            }
#pragma unroll 4
            for (int i = 0; i < 16; ++i) {
                const int tl = wave * 16 + i; const size_t t = (size_t)tb0 + tl; const float inv = invs[tl];
#pragma unroll
                for (int j = 0; j < 4; ++j) { const u32x2 hw = ((const u32x2*)(H1 + t * D))[lane + 64 * j]; const f32x4 xv = {bf2f(hw.x & 0xffff), bf2f(hw.x >> 16), bf2f(hw.y & 0xffff), bf2f(hw.y >> 16)}; const f32x4 gg = ((const f32x4*)g2)[lane + 64 * j];
                    const f32x4 o = xv * inv * gg; int w8 = __builtin_amdgcn_cvt_pk_fp8_f32(o.x, o.y, 0, false); w8 = __builtin_amdgcn_cvt_pk_fp8_f32(o.z, o.w, w8, true); ((int*)((unsigned char*)XN + t * D))[lane + 64 * j] = w8; }
            }
        }
    }
    SEAM(7);
    if (IN(8)) REP(8) gemm_ph(std::integral_constant<int, 8>{});
    SEAM(8);
    if (IN(9)) REP(9) gemm_ph(std::integral_constant<int, 9>{});
    SEAM(9);
    if (IN(10)) REP(10) {
        PHASE_PTRS
        const float* fg = AIN[27];
        for (int t = gw; t < T; t += NGW) {
            f32x4 v[4]; float ss = 0.f;
#pragma unroll
            for (int j = 0; j < 4; ++j) {
                { const u32x2 hw = ((const u32x2*)(H1 + (size_t)t * D))[lane + 64 * j]; v[j] = (f32x4){bf2f(hw.x & 0xffff), bf2f(hw.x >> 16), bf2f(hw.y & 0xffff), bf2f(hw.y >> 16)}; }
#pragma unroll
                for (int k = 0; k < TOPK; ++k) { const int w = ((const int*)((const unsigned char*)YK + ((size_t)t * TOPK + k) * D))[lane + 64 * j];
                    typedef float f32x2v __attribute__((ext_vector_type(2)));
                    const f32x2v lo2 = __builtin_amdgcn_cvt_pk_f32_fp8(w, false), hi2 = __builtin_amdgcn_cvt_pk_f32_fp8(w, true);
                    v[j].x += lo2.x * 0.0625f; v[j].y += lo2.y * 0.0625f; v[j].z += hi2.x * 0.0625f; v[j].w += hi2.y * 0.0625f; }
                ss += v[j].x * v[j].x + v[j].y * v[j].y + v[j].z * v[j].z + v[j].w * v[j].w;
            }
            ss = wave_sum(ss);
            const float inv = rsqrtf(ss * (1.f / D) + 1e-5f);
#pragma unroll
            for (int j = 0; j < 4; ++j) { const f32x4 gg = ((const f32x4*)fg)[lane + 64 * j]; ((f32x4*)(OUT + (size_t)t * D))[lane + 64 * j] = v[j] * inv * gg; }
        }
    }
#undef IN
}

constexpr int NPHASES = 11;
extern "C" void kernel_launch(void* const* d_in, const int* in_sizes, int n_in, void* d_out, int out_size, void* d_ws, size_t ws_size, hipStream_t stream) {
    static int grid = 0;
    if (grid == 0) {
        if (n_in != 28 || out_size != T * D || ws_size < WS_END) { fprintf(stderr, "kernel_launch: unexpected shapes (n_in %d out %d ws %zu)\n", n_in, out_size, ws_size); grid = -1; return; }
        if (hipFuncSetAttribute((const void*)mk_fwd, hipFuncAttributeMaxDynamicSharedMemorySize, LDS_BYTES) != hipSuccess) { fprintf(stderr, "kernel_launch: hipFuncSetAttribute failed\n"); grid = -1; return; }
        int dev = 0, cus = 0;
        if (hipGetDevice(&dev) != hipSuccess || hipDeviceGetAttribute(&cus, hipDeviceAttributeMultiprocessorCount, dev) != hipSuccess) { grid = -1; return; }
        grid = cus;
    }
    if (grid < 0) return;
    (void)hipMemsetAsync((char*)d_ws + WS_CTL, 0, CTL_BYTES, stream);
    Args a{};
    for (int i = 0; i < 28; ++i) a.in[i] = (const float*)d_in[i];
    a.out = (float*)d_out; a.ws = (unsigned char*)d_ws;
#ifndef N_LAUNCH
#define N_LAUNCH 1
#endif
    if (N_LAUNCH == 1) { a.ph_lo = 0; a.ph_hi = NPHASES; hipLaunchKernelGGL(mk_fwd, dim3(grid), dim3(NTHREADS), LDS_BYTES, stream, a); }
    else for (int p = 0; p < NPHASES; ++p) {
        a.ph_lo = p; a.ph_hi = p + 1;
        hipLaunchKernelGGL(mk_fwd, dim3(grid), dim3(NTHREADS), LDS_BYTES, stream, a);
    }
}
```

```cpp
#include <hip/hip_runtime.h>
#include <cstdint>
#include <cstdio>
#include <type_traits>

#define LAS __attribute__((address_space(3)))
typedef unsigned short bf16_t;
typedef float f32x4 __attribute__((ext_vector_type(4)));
typedef unsigned u32x2 __attribute__((ext_vector_type(2)));
typedef unsigned u32x4 __attribute__((ext_vector_type(4)));
typedef unsigned short u16x4 __attribute__((ext_vector_type(4)));

constexpr int NB = 16, SEQ = 2048, T = NB * SEQ, D = 1024;
constexpr int RW = 512, NRH = 8;
constexpr int NDH = 4;
constexpr int RCOLS = 1792, INC = 3328;
constexpr int NE = 32, TOPK = 4, DFF = 1024;
constexpr int NTHREADS = 512, NWAVES = 8;
constexpr int LDS_BYTES = 158720;
constexpr int MAXSLOT = T * TOPK + NE * 256;

constexpr size_t MiB = 1u << 20;
constexpr size_t WS_CTL = 0;
constexpr size_t CTL_BYTES = 1 * MiB;
constexpr size_t WS_LTOK = 1 * MiB, WS_LDST = 5 * MiB, WS_LGATE = 9 * MiB;
constexpr size_t WS_WIN = 16 * MiB, WS_WOUT = 24 * MiB, WS_WDN = 32 * MiB, WS_WUP = 96 * MiB;
constexpr size_t WS_WBT = 14 * MiB, WS_ABT = WS_WBT + 65536, WS_GBT = WS_ABT + 65536, WS_RWS = WS_WBT + 524288  ;
constexpr size_t WS_XN = 224 * MiB;
constexpr size_t WS_Y = 288 * MiB;
constexpr size_t WS_H1 = 352 * MiB;
constexpr size_t WS_PROJ = 480 * MiB;
constexpr size_t WS_REC = 688 * MiB;
constexpr size_t WS_RR = 688 * MiB, WS_RK = 720 * MiB, WS_RV = 752 * MiB, WS_RKK = 784 * MiB, WS_RB = 816 * MiB, WS_RG = 848 * MiB;
constexpr size_t WS_RW = 880 * MiB;
constexpr size_t WS_RKD = 944 * MiB;
constexpr size_t WS_OC = 945 * MiB;
constexpr size_t WS_ACT = 480 * MiB;
constexpr size_t WS_YK = 752 * MiB;
constexpr size_t WS_END = 1009 * MiB;

struct Args { const float* in[28]; float* out; unsigned char* ws; int ph_lo, ph_hi; };

__device__ __forceinline__ float bf2f(unsigned v) { return __uint_as_float(v << 16); }
__device__ __forceinline__ unsigned f2bf(float f) { unsigned u = __float_as_uint(f); return (u + 0x7fffu + ((u >> 16) & 1u)) >> 16; }
typedef float f32x2_t __attribute__((ext_vector_type(2))); typedef __bf16 bf16x2_t __attribute__((ext_vector_type(2)));
__device__ __forceinline__ unsigned pk2(float lo, float hi) { f32x2_t v = {lo, hi}; bf16x2_t b = __builtin_convertvector(v, bf16x2_t); return __builtin_bit_cast(unsigned, b); }
__device__ __forceinline__ float wave_sum(float v) {
#pragma unroll
    for (int o = 1; o < 64; o <<= 1) v += __shfl_xor(v, o);
    return v;
}
__device__ __forceinline__ float wave_max(float v) {
#pragma unroll
    for (int o = 1; o < 64; o <<= 1) v = fmaxf(v, __shfl_xor(v, o));
    return v;
}
template <int CTRL> __device__ __forceinline__ float dpp_f(float v) { return __int_as_float(__builtin_amdgcn_update_dpp(0, __float_as_int(v), CTRL, 0xF, 0xF, true)); }
typedef float f32x2 __attribute__((ext_vector_type(2)));
__device__ __forceinline__ float sigmoidf_(float x) { return 1.f / (1.f + __expf(-x)); }

__device__ __forceinline__ void rms_row(const float* xrow, const float* g, bf16_t* orow, int lane, float v_out[16]) {
    f32x4 v[4]; float ss = 0.f;
#pragma unroll
    for (int j = 0; j < 4; ++j) { v[j] = ((const f32x4*)xrow)[lane + 64 * j]; ss += v[j].x * v[j].x + v[j].y * v[j].y + v[j].z * v[j].z + v[j].w * v[j].w; }
    ss = wave_sum(ss);
    const float inv = rsqrtf(ss * (1.f / D) + 1e-5f);
#pragma unroll
    for (int j = 0; j < 4; ++j) {
        const f32x4 gg = ((const f32x4*)g)[lane + 64 * j];
        const f32x4 o = v[j] * inv * gg;
        v_out[4 * j + 0] = o.x; v_out[4 * j + 1] = o.y; v_out[4 * j + 2] = o.z; v_out[4 * j + 3] = o.w;
        if (orow) { u32x2 w; w.x = pk2(o.x, o.y); w.y = pk2(o.z, o.w); ((u32x2*)orow)[lane + 64 * j] = w; }
    }
}

#ifndef MFMA_GEMM
#define MFMA_GEMM 1
#endif
constexpr int NG_LD = 132;
template <class Epi>
__device__ __forceinline__ void ngemm_unit(LAS unsigned char* lds, const bf16_t* A, int lda, const float* W, int ldw, int n0, const Epi& epi) {
    LAS float* As = (LAS float*)lds; LAS float* Bs = As + 16 * NG_LD; LAS int* rowidx = (LAS int*)(Bs + 16 * NG_LD);
    const int tid = threadIdx.x, ty = tid >> 5, tx = tid & 31;
    float acc[8][4];
#pragma unroll
    for (int i = 0; i < 8; ++i)
#pragma unroll
        for (int j = 0; j < 4; ++j) acc[i][j] = 0.f;
    const int arow = tid >> 2, akq = (tid & 3) * 4;
    const int ridx = rowidx[arow]; const bf16_t* ap = A + (size_t)(ridx < 0 ? 0 : ridx) * lda + akq;
    const int bk = tid >> 5, bn = (tid & 31) * 4;
    const float* bp = W + (size_t)bk * ldw + n0 + bn;
    for (int k0 = 0; k0 < 1024; k0 += 16) {
        const u16x4 av = *(const u16x4*)(ap + k0);
        const f32x4 bv = *(const f32x4*)(bp + (size_t)k0 * ldw);
        __syncthreads();
        As[(akq + 0) * NG_LD + arow] = bf2f(av.x); As[(akq + 1) * NG_LD + arow] = bf2f(av.y); As[(akq + 2) * NG_LD + arow] = bf2f(av.z); As[(akq + 3) * NG_LD + arow] = bf2f(av.w);
        *(LAS f32x4*)(Bs + bk * NG_LD + bn) = bv;
        __syncthreads();
#pragma unroll 4
        for (int k = 0; k < 16; ++k) {
            const f32x4 a0 = *(const LAS f32x4*)(As + k * NG_LD + ty * 8), a1 = *(const LAS f32x4*)(As + k * NG_LD + ty * 8 + 4);
            const f32x4 b = *(const LAS f32x4*)(Bs + k * NG_LD + tx * 4);
            const float a[8] = {a0.x, a0.y, a0.z, a0.w, a1.x, a1.y, a1.z, a1.w};
#pragma unroll
            for (int i = 0; i < 8; ++i) { acc[i][0] += a[i] * b.x; acc[i][1] += a[i] * b.y; acc[i][2] += a[i] * b.z; acc[i][3] += a[i] * b.w; }
        }
    }
#pragma unroll
    for (int i = 0; i < 8; ++i) { const int r = ty * 8 + i; epi(r, rowidx[r], n0 + tx * 4, (f32x4){acc[i][0], acc[i][1], acc[i][2], acc[i][3]}); }
    __syncthreads();
}


namespace pg8 {
typedef short bf16x8 __attribute__((ext_vector_type(8)));
constexpr int BM = 256, BK = 64, HALF = 128, HTB = HALF * BK * 2;
__device__ __forceinline__ int lds_byte(int r, int c) { const int st = (r >> 4) * 2 + (c >> 5), rr = r & 15, cc = c & 31, ob = rr * 64 + cc * 2; return st * 1024 + (ob ^ (((ob >> 9) & 1) << 5)); }
__device__ __forceinline__ void stage_rc(int b, int& R, int& C) { const int st = b / 1024, sb = b % 1024, swz = sb ^ (((sb >> 9) & 1) << 5); R = (st >> 1) * 16 + swz / 64; C = (st & 1) * 32 + (swz % 64) / 2; }
__device__ __forceinline__ int perm32(int rho) { const int n = rho >> 4, i = rho & 15; return 8 * (i >> 2) + 4 * n + (i & 3); }
__device__ __forceinline__ int perm64(int R) { const int wc = R >> 5, n = (R >> 4) & 1, i = R & 15; return 64 * wc + 16 * (i >> 2) + 4 * n + (i & 3); }
struct Unit { int pm, pn, e, ct, r0, cn, sb; };
__device__ __forceinline__ unsigned cvt_pk_bf16(float lo, float hi) { unsigned r; asm volatile("v_cvt_pk_bf16_f32 %0, %1, %2" : "=v"(r) : "v"(lo), "v"(hi)); return r; }

template <bool FP8> struct FragT;
template <> struct FragT<false> {
    struct A { bf16x8 k[2]; };
    static __device__ __forceinline__ void load(A& d, const LAS unsigned char* p) { d.k[0] = *(const LAS bf16x8*)p; d.k[1] = *(const LAS bf16x8*)(p + 1024); }
    static __device__ __forceinline__ void mma(f32x4& acc, const A& b, const A& a) {
        acc = __builtin_amdgcn_mfma_f32_16x16x32_bf16(b.k[0], a.k[0], acc, 0, 0, 0); acc = __builtin_amdgcn_mfma_f32_16x16x32_bf16(b.k[1], a.k[1], acc, 0, 0, 0); }
};
typedef int i32x8 __attribute__((ext_vector_type(8)));
template <> struct FragT<true> {
    typedef i32x8 A;
    static __device__ __forceinline__ void load(A& d, const LAS unsigned char* p) { typedef int i32x4 __attribute__((ext_vector_type(4)));
        const i32x4 lo = *(const LAS i32x4*)p, hi = *(const LAS i32x4*)(p + 1024); d = __builtin_shufflevector(lo, hi, 0, 1, 2, 3, 4, 5, 6, 7); }
    static __device__ __forceinline__ void mma(f32x4& acc, const A& b, const A& a) { acc = __builtin_amdgcn_mfma_scale_f32_16x16x128_f8f6f4(b, a, acc, 0, 0, 0, 0x7f7f7f7f, 0, 0x7f7f7f7f); }
};
template <class Epi, class Sched, class RowOff, bool ALIGN_EPI, bool FP8>
__device__ __forceinline__ void gemm_phase(LAS unsigned char* lds, const bf16_t* Aptr, const bf16_t* Btptr, const Sched& S, const RowOff& RO, const Epi& E, int wid, int lane) {
    constexpr int K = 1024, ROWB = FP8 ? 1024 : 2048, nt = FP8 ? K / 128 : K / BK;
    const int tid = wid * 64 + lane, wr = wid >> 2, wc = wid & 3, fr = lane & 15, fq = lane >> 4;
    int RA[2]; unsigned CA[2], voffB[2];
#pragma unroll
    for (int i = 0; i < 2; ++i) { int R, C; stage_rc(tid * 16 + i * 8192, R, C); const int Rb = Epi::brow(R);
        RA[i] = R; CA[i] = (unsigned)C * 2u; voffB[i] = (unsigned)(Rb * ROWB + C * 2); }
    constexpr size_t kstep = (size_t)(BK * 2);
    constexpr size_t hstep = (size_t)8 * ROWB;
    constexpr size_t tstep = (size_t)BM * ROWB;
    const unsigned ldsw = (unsigned)wid * 1024u;
    const int aoff = lds_byte(wr * 64 + fr, fq * 8), boff = lds_byte(wc * 32 + fr, fq * 8);
#define PG8_SA(b, h) (((b) * 2 + (h)) * HTB)
#define PG8_SB(b, h) ((4 + (b) * 2 + (h)) * HTB)
#define PG8_STAGE(bufoff, gbase, voff) do { _Pragma("unroll") for (int _i = 0; _i < 2; ++_i) \
        __builtin_amdgcn_global_load_lds((const unsigned*)((const char*)(gbase) + (voff)[_i]), (LAS unsigned*)(lds + (bufoff) + ldsw + _i * 8192), 16, 0, 0); } while (0)
#define PG8_STAGEA(bufoff, kb, v0, v1) do { \
        __builtin_amdgcn_global_load_lds((const unsigned*)((const char*)Aptr + (size_t)(kb) + (v0)), (LAS unsigned*)(lds + (bufoff) + ldsw), 16, 0, 0); \
        __builtin_amdgcn_global_load_lds((const unsigned*)((const char*)Aptr + (size_t)(kb) + (v1)), (LAS unsigned*)(lds + (bufoff) + ldsw + 8192), 16, 0, 0); } while (0)
#define PG8_LDA(dst, b, h) do { _Pragma("unroll") for (int m = 0; m < 4; ++m) FragT<FP8>::load(dst[m], lds + PG8_SA(b, h) + aoff + m * 2048); } while (0)
#define PG8_LDB(dst, b, h) do { _Pragma("unroll") for (int n = 0; n < 2; ++n) FragT<FP8>::load(dst[n], lds + PG8_SB(b, h) + boff + n * 2048); } while (0)
#define PG8_MMA(ai, bj, At, Bt) do { __builtin_amdgcn_s_setprio(1); _Pragma("unroll") for (int m = 0; m < 4; ++m) _Pragma("unroll") for (int n = 0; n < 2; ++n) { \
        FragT<FP8>::mma(acc[ai][bj][m][n], Bt[n], At[m]); } __builtin_amdgcn_s_setprio(0); } while (0)
#define PG8_WAIT_V(n) asm volatile("s_waitcnt vmcnt(" #n ")" ::: "memory")
#define PG8_WAIT_L(n) asm volatile("s_waitcnt lgkmcnt(" #n ")" ::: "memory")
#define PG8_BAR __builtin_amdgcn_s_barrier()
#define PG8_SCHED __builtin_amdgcn_sched_barrier(0)
    Unit cur, nxt; int ui = 0;
    if (!S.next(0, cur)) return;
    f32x4 acc[2][2][4][2];
#pragma unroll
    for (int a = 0; a < 2; ++a)
#pragma unroll
        for (int b = 0; b < 2; ++b)
#pragma unroll
            for (int m = 0; m < 4; ++m)
#pragma unroll
                for (int n = 0; n < 2; ++n) acc[a][b][m][n] = (f32x4){0.f, 0.f, 0.f, 0.f};
    typename FragT<FP8>::A At[4]; typename FragT<FP8>::A B0[2], B1[2];
    unsigned c00, c01, c10, c11;
    LAS unsigned* rscr = (LAS unsigned*)(lds + 131072 + 4096 + wid * 1024);
    LAS unsigned char* escr = lds + 131072 + 4096 + 8192;
    RO.issue(cur, RA[0], RA[1], rscr); asm volatile("s_waitcnt vmcnt(0)" ::: "memory");
    RO.finish(cur, RA[0], RA[1], rscr, c00, c01, c10, c11); c00 += CA[0]; c01 += CA[1]; c10 += CA[0]; c11 += CA[1];
    const char* cB = (const char*)Btptr + (size_t)cur.pn * tstep;
    PG8_STAGE(PG8_SB(0, 0), cB, voffB); PG8_STAGE(PG8_SB(0, 1), cB + hstep, voffB); PG8_STAGEA(PG8_SA(0, 0), 0, c00, c01); PG8_STAGEA(PG8_SA(0, 1), 0, c10, c11);
    if (wr == 1) PG8_BAR;
    PG8_WAIT_V(2); PG8_BAR;
    PG8_STAGE(PG8_SB(1, 0), cB + kstep, voffB); PG8_STAGEA(PG8_SA(1, 0), kstep, c00, c01); PG8_STAGE(PG8_SB(1, 1), cB + hstep + kstep, voffB);
    PG8_WAIT_V(6); PG8_BAR;
    for (;;) {
        const bool has_next = S.next(ui + 1, nxt);
        E.issue(cur, escr + (ui & 1) * 3072, wid, lane);
        if (has_next) RO.issue(nxt, RA[0], RA[1], rscr);
        const char* nB = has_next ? (const char*)Btptr + (size_t)nxt.pn * tstep : cB;
#pragma unroll 1
        for (int t = 0; t < nt; t += 2) {
            const bool last = (t == nt - 2);
            const size_t k1 = (size_t)(t + 1) * kstep;
            const size_t k2 = last ? 0 : (size_t)(t + 2) * kstep, k3 = k2 + kstep;
            const char* b2 = last ? nB : cB + (size_t)(t + 2) * kstep; const char* b3 = b2 + kstep;
            PG8_LDB(B0, 0, 0); PG8_LDB(B1, 0, 1); PG8_SCHED; PG8_LDA(At, 0, 0); PG8_STAGEA(PG8_SA(1, 1), k1, c10, c11);
            E.touch(cur, t, escr, wid, lane);
            if (last && has_next) { RO.finish(nxt, RA[0], RA[1], rscr, c00, c01, c10, c11); c00 += CA[0]; c01 += CA[1]; c10 += CA[0]; c11 += CA[1]; }
            PG8_WAIT_V(8); PG8_WAIT_L(0); PG8_BAR; PG8_MMA(0, 0, At, B0); PG8_MMA(0, 1, At, B1); PG8_BAR; PG8_SCHED;
            PG8_LDA(At, 0, 1); PG8_STAGE(PG8_SB(0, 0), b2, voffB); PG8_STAGE(PG8_SB(0, 1), b2 + hstep, voffB); PG8_STAGEA(PG8_SA(0, 0), k2, c00, c01);
            PG8_WAIT_V(8); PG8_WAIT_L(0); PG8_BAR; PG8_MMA(1, 0, At, B0); PG8_MMA(1, 1, At, B1); PG8_BAR; PG8_SCHED;
            PG8_LDB(B0, 1, 0); PG8_LDB(B1, 1, 1); PG8_SCHED; PG8_LDA(At, 1, 0); PG8_STAGEA(PG8_SA(0, 1), k2, c10, c11);
            PG8_WAIT_V(8); PG8_WAIT_L(0); PG8_BAR; PG8_MMA(0, 0, At, B0); PG8_MMA(0, 1, At, B1); PG8_BAR; PG8_SCHED;
            PG8_LDA(At, 1, 1); PG8_STAGE(PG8_SB(1, 0), b3, voffB); PG8_STAGE(PG8_SB(1, 1), b3 + hstep, voffB); PG8_STAGEA(PG8_SA(1, 0), k3, c00, c01);
            PG8_WAIT_V(8); PG8_WAIT_L(0); PG8_BAR; PG8_MMA(1, 0, At, B0); PG8_MMA(1, 1, At, B1); PG8_BAR; PG8_SCHED;
        }
        if constexpr (ALIGN_EPI) { if (wr == 0) PG8_BAR; }
        E(acc, cur, wr, wc, fr, fq, escr + (ui & 1) * 3072, (LAS unsigned char*)rscr, lds + 131072 + 4096 + 8192 + 6144 + wid * 1024);
        if (!has_next) break;
#pragma unroll
        for (int a = 0; a < 2; ++a)
#pragma unroll
            for (int b = 0; b < 2; ++b)
#pragma unroll
                for (int m = 0; m < 4; ++m)
#pragma unroll
                    for (int n = 0; n < 2; ++n) acc[a][b][m][n] = (f32x4){0.f, 0.f, 0.f, 0.f};
        cur = nxt; cB = nB; ++ui;
        if constexpr (ALIGN_EPI) { if (wr == 1) PG8_BAR; }
    }
    PG8_WAIT_V(0);
    if constexpr (!ALIGN_EPI) { if (wr == 0) PG8_BAR; }
    PG8_BAR;
#undef PG8_SA
#undef PG8_SB
#undef PG8_STAGE
#undef PG8_STAGEA
#undef PG8_LDA
#undef PG8_LDB
#undef PG8_MMA
#undef PG8_WAIT_V
#undef PG8_WAIT_L
#undef PG8_BAR
#undef PG8_SCHED
}

struct DenseOrder {
    int nM, nN, nwg, G, c;
    __device__ void init(int M, int N, int G_, int c_) { nM = M / BM; nN = N / BM; nwg = nM * nN; G = G_; c = c_; }
    __device__ bool next(int i, Unit& u) const {
        const long L = (long)i * G + c; if (L >= nwg) return false;
        int wgid = (int)L; { const int q = nwg / 8, r = nwg % 8, xcd = wgid % 8, off = wgid / 8; wgid = (xcd < r ? xcd * (q + 1) : r * (q + 1) + (xcd - r) * q) + off; }
        const int nig = 8 * nN, gid = wgid / nig, fm = gid * 8, gsz = (nM - fm) < 8 ? (nM - fm) : 8;
        u.pm = fm + ((wgid % nig) % gsz); u.pn = (wgid % nig) / gsz; u.e = 0; u.ct = u.pn; u.r0 = 0; u.cn = 0; u.sb = 0; return true;
    }
};
struct MoeOrder {
    const LAS int* meta; int nct, G, c, nunits;
    __device__ bool next(int i, Unit& u) const {
        const int x = c & 7, y = c >> 3, rpx = 32 / nct;
        const int rt = i * 8 * rpx + x * rpx + (y % rpx), ct = y / rpx;
        if (rt >= nunits / nct) return false;
        const int e = meta[256 + rt];
        u.e = e; u.ct = ct; u.r0 = (rt - meta[e]) * BM; u.cn = meta[128 + e]; u.sb = meta[64 + e]; u.pm = (u.sb + u.r0) / BM; u.pn = e * nct + ct; return true;
    }
};
struct RowDense { unsigned rowb;
    __device__ __forceinline__ void issue(const Unit&, int, int, LAS unsigned*) const {}
    __device__ __forceinline__ void finish(const Unit& u, int R0, int R1, LAS unsigned*, unsigned& o00, unsigned& o01, unsigned& o10, unsigned& o11) const {
    const unsigned base = (unsigned)u.pm * BM; o00 = (base + R0) * rowb; o01 = (base + R1) * rowb; o10 = (base + 128 + R0) * rowb; o11 = (base + 128 + R1) * rowb; } };
struct RowGather { const int* ltok; unsigned rowb;
    __device__ __forceinline__ void issue(const Unit& u, int R0, int R1, LAS unsigned* scr) const {
        const int* lp = ltok + (size_t)u.e * T + u.r0; const int lim = u.cn - u.r0 - 1;
        const int i00 = R0 < lim ? R0 : lim, i01 = R1 < lim ? R1 : lim, i10 = 128 + R0 < lim ? 128 + R0 : lim, i11 = 128 + R1 < lim ? 128 + R1 : lim;
        __builtin_amdgcn_global_load_lds((const unsigned*)(lp + i00), scr, 4, 0, 0); __builtin_amdgcn_global_load_lds((const unsigned*)(lp + i01), scr + 64, 4, 0, 0);
        __builtin_amdgcn_global_load_lds((const unsigned*)(lp + i10), scr + 128, 4, 0, 0); __builtin_amdgcn_global_load_lds((const unsigned*)(lp + i11), scr + 192, 4, 0, 0); }
    __device__ __forceinline__ void finish(const Unit&, int, int, LAS unsigned* scr, unsigned& o00, unsigned& o01, unsigned& o10, unsigned& o11) const {
        const int lane_ = (int)__builtin_amdgcn_mbcnt_hi(~0u, __builtin_amdgcn_mbcnt_lo(~0u, 0u));
        o00 = scr[lane_] * rowb; o01 = scr[64 + lane_] * rowb; o10 = scr[128 + lane_] * rowb; o11 = scr[192 + lane_] * rowb; } };
__device__ __forceinline__ u32x4 quad_rows(const u32x4 w, LAS unsigned char* tscr, int fr, int fq, int l) {
    *(LAS u32x4*)(tscr + (4 * fr + (fq ^ ((fr >> 1) & 3))) * 16) = w;
    return *(const LAS u32x4*)(tscr + ((l & ~3) + ((l & 3) ^ ((l >> 3) & 3))) * 16);
}
__device__ __forceinline__ void line_rows(const u32x4 w0, const u32x4 w1, u32x4& o0, u32x4& o1, LAS unsigned char* t0, LAS unsigned char* t1, int fr, int fq, int l) {
    LAS unsigned char* wp = ((fr & 8) ? t1 : t0) + (fr & 7) * 128;
    *(LAS u32x4*)(wp + (((2 * fq) ^ (fr & 7)) * 16)) = w0; *(LAS u32x4*)(wp + (((2 * fq + 1) ^ (fr & 7)) * 16)) = w1;
    const int ro = (l >> 3) * 128 + (((l & 7) ^ (l >> 3)) * 16);
    o0 = *(const LAS u32x4*)(t0 + ro); o1 = *(const LAS u32x4*)(t1 + ro);
}
struct EpiProj { bf16_t* O;
    static __device__ __forceinline__ int brow(int R) { return perm64(R); }
    __device__ __forceinline__ void issue(const Unit&, LAS unsigned char*, int, int) const {}
    __device__ __forceinline__ void touch(const Unit&, int, LAS unsigned char*, int, int) const {}
    __device__ __forceinline__ void operator()(const f32x4 (&acc)[2][2][4][2], const Unit& u, int wr, int wc, int fr, int fq, const LAS unsigned char*, LAS unsigned char* t0, LAS unsigned char* t1) const {
        asm volatile("" : "+v"(fr), "+v"(fq));
        const int l = fr + 16 * fq;
        bf16_t* op = O + (size_t)(u.pm * BM + wr * 64 + (l >> 3)) * INC + u.ct * BM + wc * 64 + 8 * (l & 7);
#pragma unroll
        for (int ai = 0; ai < 2; ++ai)
#pragma unroll
            for (int m = 0; m < 4; ++m) { u32x4 w[2], o0, o1;
#pragma unroll
                for (int bj = 0; bj < 2; ++bj) { const f32x4 v0 = acc[ai][bj][m][0], v1 = acc[ai][bj][m][1];
                    w[bj].x = cvt_pk_bf16(v0[0], v0[1]); w[bj].y = cvt_pk_bf16(v0[2], v0[3]); w[bj].z = cvt_pk_bf16(v1[0], v1[1]); w[bj].w = cvt_pk_bf16(v1[2], v1[3]); }
                line_rows(w[0], w[1], o0, o1, t0, t1, fr, fq, l);
                bf16_t* rp = op + (size_t)(ai * HALF + m * 16) * INC; *(u32x4*)rp = o0; *(u32x4*)(rp + (size_t)8 * INC) = o1; }
    } };
struct EpiOut { const float* X; bf16_t* H;
    static __device__ __forceinline__ int brow(int R) { return perm64(R); }
    __device__ __forceinline__ void issue(const Unit&, LAS unsigned char*, int, int) const {}
    __device__ __forceinline__ void touch(const Unit& u, int t, LAS unsigned char* scr, int wid, int lane) const {
        if ((t & 3) == 0) { const int idx = ((t >> 2) * 8 + wid) * 64 + lane;
            __builtin_amdgcn_global_load_lds((const unsigned*)(X + (size_t)(u.pm * BM + (idx >> 3)) * D + u.ct * BM + (idx & 7) * 32), (LAS unsigned*)(scr + wid * 256), 4, 0, 0); } }
    static __device__ __forceinline__ int gperm(int r) { return ((r >> 1) & 1) | ((r & 1) << 1) | (r & 4); }
    __device__ __forceinline__ void operator()(const f32x4 (&acc)[2][2][4][2], const Unit& u, int wr, int wc, int fr, int fq, const LAS unsigned char*, LAS unsigned char* t0, LAS unsigned char* t1) const {
        asm volatile("" : "+v"(fr), "+v"(fq));
        const int l = fr + 16 * fq;
        LAS unsigned char* wb = ((fq >> 1) ? t1 : t0) + (fr & 7) * 128; const int gw = gperm(fr & 7), wc0 = 4 * (fq & 1);
        const int rr = l >> 3, cp = l & 7, gr = gperm(rr);
        const LAS unsigned char* rb = ((cp >> 2) ? t1 : t0) + rr * 128; const int ra0 = ((2 * (cp & 3)) ^ gr) * 16, ra1 = ((2 * (cp & 3) + 1) ^ gr) * 16;
        const size_t gro = (size_t)(u.pm * BM + wr * 64 + rr) * D + u.ct * BM + wc * 64 + 8 * cp;
        const float* xp = X + gro; bf16_t* hp = H + gro;
        f32x4 xa[2][2];
#define EO_RO(i) ((size_t)((((i) >> 3) * HALF + (((i) >> 1) & 3) * 16 + 8 * ((i) & 1)) * D))
        xa[0][0] = *(const f32x4*)(xp + EO_RO(0)); xa[0][1] = *(const f32x4*)(xp + EO_RO(0) + 4); xa[1][0] = *(const f32x4*)(xp + EO_RO(1)); xa[1][1] = *(const f32x4*)(xp + EO_RO(1) + 4);
#pragma unroll
        for (int i = 0; i < 16; ++i) { const int ai = i >> 3, m = (i >> 1) & 3, p = i & 1;
            if ((fr >> 3) == p) {
#pragma unroll
                for (int j = 0; j < 4; ++j) *(LAS f32x4*)(wb + (((wc0 + j) ^ gw) * 16)) = acc[ai][j >> 1][m][j & 1]; }
            const f32x4 v0 = *(const LAS f32x4*)(rb + ra0) + xa[i & 1][0], v1 = *(const LAS f32x4*)(rb + ra1) + xa[i & 1][1];
            if (i + 2 < 16) { xa[i & 1][0] = *(const f32x4*)(xp + EO_RO(i + 2)); xa[i & 1][1] = *(const f32x4*)(xp + EO_RO(i + 2) + 4); }
            u32x4 w; w.x = cvt_pk_bf16(v0[0], v0[1]); w.y = cvt_pk_bf16(v0[2], v0[3]); w.z = cvt_pk_bf16(v1[0], v1[1]); w.w = cvt_pk_bf16(v1[2], v1[3]);
            *(u32x4*)(hp + EO_RO(i)) = w; }
#undef EO_RO
    } };
struct EpiUp { bf16_t* ACTp; const float* bup; float wscale;
    static __device__ __forceinline__ int brow(int R) { const int p = perm64(R); return (p & ~3) | ((p & 1) << 1) | ((p >> 1) & 1); }
    __device__ __forceinline__ void issue(const Unit& u, LAS unsigned char* scr, int wid, int lane) const {
        if (wid == 0) __builtin_amdgcn_global_load_lds((const unsigned*)(bup + (size_t)u.e * 2 * DFF + u.ct * BM + 4 * lane), (LAS unsigned*)scr, 16, 0, 0); }
    __device__ __forceinline__ void touch(const Unit&, int, LAS unsigned char*, int, int) const {}
    __device__ __forceinline__ void operator()(const f32x4 (&acc)[2][2][4][2], const Unit& u, int wr, int wc, int fr, int fq, const LAS unsigned char* scr, LAS unsigned char* t0, LAS unsigned char*) const {
        asm volatile("" : "+v"(fr), "+v"(fq));
        typedef float f32x2 __attribute__((ext_vector_type(2)));
        const int l = fr + 16 * fq;
        const LAS float* bp = (const LAS float*)scr + wc * 64 + 16 * fq;
        f32x4 bb[4];
#pragma unroll
        for (int j = 0; j < 4; ++j) { const f32x4 t = *(const LAS f32x4*)(bp + 4 * j); bb[j] = (f32x4){t.x, t.z, t.y, t.w}; asm volatile("" : "+v"(bb[j])); }
        const int ro = (l >> 1) * 32 + (((l & 1) ^ ((l >> 3) & 1)) * 16);
        const int rl1 = wr * 64 + (l >> 1);
        unsigned char* op = (unsigned char*)ACTp + (size_t)(u.sb + u.r0 + rl1) * DFF + u.ct * (BM / 2) + wc * 32 + 16 * (l & 1);
        const f32x2 c7 = {7.f, 7.f}, one = {1.f, 1.f}; const float ke = -1.702f * 1.4426950408889634f;
#pragma unroll
        for (int q = 0; q < 4; ++q) { const int ai = q >> 1;
#pragma unroll
            for (int mm = 0; mm < 2; ++mm) { const int m = 2 * (q & 1) + mm; u32x2 w8; w8.x = 0u; w8.y = 0u;
                if (u.r0 + wr * 64 + fr + ai * HALF + m * 16 < u.cn) {
#pragma unroll
                    for (int bj = 0; bj < 2; ++bj) { f32x2 a[2];
#pragma unroll
                        for (int n = 0; n < 2; ++n) { const f32x4 v = acc[ai][bj][m][n] * wscale + bb[2 * bj + n];
                            const f32x2 gl = {fminf(v.x, 7.f), fminf(v.y, 7.f)}, li = {__builtin_amdgcn_fmed3f(v.z, -7.f, 7.f), __builtin_amdgcn_fmed3f(v.w, -7.f, 7.f)};
                            const f32x2 ex = gl * ke; const f32x2 dn = (f32x2){__builtin_amdgcn_exp2f(ex.x), __builtin_amdgcn_exp2f(ex.y)} + one;
                            a[n] = gl * (li + one) * (f32x2){__builtin_amdgcn_rcpf(dn.x), __builtin_amdgcn_rcpf(dn.y)}; }
                        int t8 = __builtin_amdgcn_cvt_pk_fp8_f32(a[0].x, a[0].y, 0, false); t8 = __builtin_amdgcn_cvt_pk_fp8_f32(a[1].x, a[1].y, t8, true);
                        if (bj) w8.y = (unsigned)t8; else w8.x = (unsigned)t8; } }
                const int row = 16 * mm + fr;
                *(LAS u32x2*)(t0 + row * 32 + ((fq ^ (((row >> 2) & 1) * 2)) * 8)) = w8; }
            const u32x4 o = *(const LAS u32x4*)(t0 + ro);
            const int rl = rl1 + ai * HALF + 32 * (q & 1);
            if (u.r0 + rl < u.cn) *(u32x4*)(op + (size_t)(ai * HALF + 32 * (q & 1)) * DFF) = o; }
    } };
struct EpiDown { bf16_t* YKp; const float* bdn; const int* ldst; const float* lgate; float wscale;
    static __device__ __forceinline__ int brow(int R) { return perm64(R); }
    __device__ __forceinline__ void issue(const Unit& u, LAS unsigned char* scr, int wid, int lane) const {
        const size_t li = (size_t)u.e * T + u.r0 + 4 * lane;
        if (wid == 0) __builtin_amdgcn_global_load_lds((const unsigned*)(bdn + (size_t)u.e * D + u.ct * BM + 4 * lane), (LAS unsigned*)scr, 16, 0, 0);
        else if (wid == 1) __builtin_amdgcn_global_load_lds((const unsigned*)(lgate + li), (LAS unsigned*)(scr + 1024), 16, 0, 0);
        else if (wid == 2) __builtin_amdgcn_global_load_lds((const unsigned*)(ldst + li), (LAS unsigned*)(scr + 2048), 16, 0, 0); }
    __device__ __forceinline__ void touch(const Unit&, int, LAS unsigned char*, int, int) const {}
    __device__ __forceinline__ void operator()(const f32x4 (&acc)[2][2][4][2], const Unit& u, int wr, int wc, int fr, int fq, const LAS unsigned char* scr, LAS unsigned char* t0, LAS unsigned char*) const {
        asm volatile("" : "+v"(fr), "+v"(fq));
        const int l = fr + 16 * fq;
        const LAS float* bp = (const LAS float*)scr + wc * 64 + 16 * fq; const LAS float* gp = (const LAS float*)(scr + 1024); const LAS int* dp = (const LAS int*)(scr + 2048);
        const f32x4 b00 = *(const LAS f32x4*)(bp), b01 = *(const LAS f32x4*)(bp + 4), b10 = *(const LAS f32x4*)(bp + 8), b11 = *(const LAS f32x4*)(bp + 12);
        const int rl0 = wr * 64 + fr, rl1 = wr * 64 + (l >> 2), colb = u.ct * BM + wc * 64 + 16 * (l & 3);
#pragma unroll
        for (int q = 0; q < 8; ++q) { const int ai = q >> 2, m = q & 3;
            const float g = gp[rl0 + ai * HALF + m * 16] * 16.f;
            u32x4 w;
#pragma unroll
            for (int bj = 0; bj < 2; ++bj) { const f32x4 v0 = (acc[ai][bj][m][0] * wscale + (bj ? b10 : b00)) * g, v1 = (acc[ai][bj][m][1] * wscale + (bj ? b11 : b01)) * g;
                int lo = __builtin_amdgcn_cvt_pk_fp8_f32(v0[0], v0[1], 0, false); lo = __builtin_amdgcn_cvt_pk_fp8_f32(v0[2], v0[3], lo, true);
                int hi = __builtin_amdgcn_cvt_pk_fp8_f32(v1[0], v1[1], 0, false); hi = __builtin_amdgcn_cvt_pk_fp8_f32(v1[2], v1[3], hi, true);
                if (bj) { w.z = (unsigned)lo; w.w = (unsigned)hi; } else { w.x = (unsigned)lo; w.y = (unsigned)hi; } }
            const u32x4 o = quad_rows(w, t0, fr, fq, l);
            const int rl = rl1 + ai * HALF + m * 16;
            if (u.r0 + rl < u.cn) *(u32x4*)((unsigned char*)YKp + (size_t)dp[rl] * D + colb) = o; }
    } };
}

__device__ __forceinline__ void transpose_item(const float* W, int K, int N, bf16_t* WT, LAS float*, int item, int lane) {
    const int nblk = N / 32, kb = item / nblk, nb = item % nblk, k0 = 64 * kb + 8 * (lane >> 3), n0 = 32 * nb + 4 * (lane & 7);
    f32x4 wv[8];
#pragma unroll
    for (int i = 0; i < 8; ++i) wv[i] = *(const f32x4*)(W + (size_t)(k0 + i) * N + n0);
#pragma unroll
    for (int q = 0; q < 4; ++q) { u32x4 o; o.x = pk2(wv[0][q], wv[1][q]); o.y = pk2(wv[2][q], wv[3][q]); o.z = pk2(wv[4][q], wv[5][q]); o.w = pk2(wv[6][q], wv[7][q]);
        *(u32x4*)(WT + (size_t)(n0 + q) * K + k0) = o; }
}

struct CvItem { const float* src; unsigned char* dst; int N, K; };
__device__ __forceinline__ CvItem cv_item(int r, const float* wup, const float* wdn, unsigned char* WUP8, unsigned char* WDN8, int lane) {
    constexpr int I_UP = 16 * (2 * DFF / 32), I_DN = 16 * (D / 32);
    CvItem it; const float* W; unsigned char* WT; int item;
    if (r < NE * I_UP) { const int e = r / I_UP; W = wup + (size_t)e * D * 2 * DFF; WT = WUP8 + (size_t)e * 2 * DFF * D; it.K = D; it.N = 2 * DFF; item = r % I_UP; }
    else { r -= NE * I_UP; const int e = r / I_DN; W = wdn + (size_t)e * DFF * D; WT = WDN8 + (size_t)e * D * DFF; it.K = DFF; it.N = D; item = r % I_DN; }
    const int nblk = it.N / 32, kb = item / nblk, nb = item % nblk, k0 = 64 * kb, n0 = 32 * nb;
    it.src = W + (size_t)(k0 + 8 * (lane >> 3)) * it.N + n0 + 4 * (lane & 7);
    it.dst = WT + (size_t)(n0 + 4 * (lane & 7)) * it.K + k0 + 8 * (lane >> 3);
    return it;
}
__device__ __forceinline__ void cv_load(f32x4 (&wv)[8], const CvItem& it) {
#pragma unroll
    for (int i = 0; i < 8; ++i) wv[i] = *(const f32x4*)(it.src + (size_t)i * it.N);
}
__device__ __forceinline__ void cv_finish(const f32x4 (&wv)[8], const CvItem& it, LAS float*, int) {
#pragma unroll
    for (int q = 0; q < 4; ++q) {
        int lo = __builtin_amdgcn_cvt_pk_fp8_f32(wv[0][q] * 32.f, wv[1][q] * 32.f, 0, false); lo = __builtin_amdgcn_cvt_pk_fp8_f32(wv[2][q] * 32.f, wv[3][q] * 32.f, lo, true);
        int hi = __builtin_amdgcn_cvt_pk_fp8_f32(wv[4][q] * 32.f, wv[5][q] * 32.f, 0, false); hi = __builtin_amdgcn_cvt_pk_fp8_f32(wv[6][q] * 32.f, wv[7][q] * 32.f, hi, true);
        u32x2 o; o.x = (unsigned)lo; o.y = (unsigned)hi;
        *(u32x2*)(it.dst + (size_t)q * it.K) = o; }
}

constexpr int CV_PER = 64, CV_ITEMS = NE * (16 * (2 * DFF / 32) + 16 * (D / 32)), CV_TICKETS = CV_ITEMS / CV_PER;
__device__ __forceinline__ void convert_ticket(int ticket, const float* wup, const float* wdn, unsigned char* WUP8, unsigned char* WDN8, LAS float* scr, int wave, int lane) {
    const int base = ticket * CV_PER + wave;
    f32x4 wa[8], wb[8];
    CvItem ia = cv_item(base, wup, wdn, WUP8, WDN8, lane), ib;
    cv_load(wa, ia);
#pragma unroll 1
    for (int j = 0; j < CV_PER / NWAVES; j += 2) {
        ib = cv_item(base + (j + 1) * NWAVES, wup, wdn, WUP8, WDN8, lane); cv_load(wb, ib);
        cv_finish(wa, ia, scr, lane);
        if (j + 2 < CV_PER / NWAVES) { ia = cv_item(base + (j + 2) * NWAVES, wup, wdn, WUP8, WDN8, lane); cv_load(wa, ia); }
        cv_finish(wb, ib, scr, lane);
    }
}

namespace rk {
__device__ __forceinline__ unsigned hpk(float lo, float hi) { return pk2(lo, hi); }
typedef short bf16x8 __attribute__((ext_vector_type(8)));
typedef float f32x16 __attribute__((ext_vector_type(16)));
constexpr int RS64 = 144, RS32 = 80;
__device__ __forceinline__ bf16x8 frag(const LAS unsigned char* base, int RS, int row0, int k0, int r32, int hi) { return *(const LAS bf16x8*)(base + (row0 + r32) * RS + (k0 + 8 * hi) * 2); }
__device__ __forceinline__ bf16x8 negf(bf16x8 a) { u32x4 w = __builtin_bit_cast(u32x4, a); w.x ^= 0x80008000u; w.y ^= 0x80008000u; w.z ^= 0x80008000u; w.w ^= 0x80008000u; return __builtin_bit_cast(bf16x8, w); }
template <int NK, bool NEG> __device__ __forceinline__ void mm(f32x16& acc, const LAS unsigned char* A, int ARS, int arow0, const LAS unsigned char* B, int BRS, int brow0, int r32, int hi) {
#pragma unroll
    for (int s = 0; s < NK; ++s) { bf16x8 a = frag(A, ARS, arow0, 16 * s, r32, hi); if (NEG) a = negf(a);
        acc = __builtin_amdgcn_mfma_f32_32x32x16_bf16(a, frag(B, BRS, brow0, 16 * s, r32, hi), acc, 0, 0, 0); }
}
__device__ __forceinline__ void tstore(const f32x16& acc, LAS unsigned char* base, int RS, int drow0, int dcol0, int r32, int hi) {
#pragma unroll
    for (int g = 0; g < 4; ++g) { u32x2 w; w.x = hpk(acc[4 * g], acc[4 * g + 1]); w.y = hpk(acc[4 * g + 2], acc[4 * g + 3]);
        *(LAS u32x2*)(base + (drow0 + r32) * RS + (dcol0 + 8 * g + 4 * hi) * 2) = w; }
}
__device__ __forceinline__ void tload(f32x16& acc, const LAS unsigned char* base, int RS, int drow0, int dcol0, int r32, int hi) {
#pragma unroll
    for (int g = 0; g < 4; ++g) { const u32x2 w = *(const LAS u32x2*)(base + (drow0 + r32) * RS + (dcol0 + 8 * g + 4 * hi) * 2);
        acc[4 * g] = bf2f(w.x & 0xffff); acc[4 * g + 1] = bf2f(w.x >> 16); acc[4 * g + 2] = bf2f(w.y & 0xffff); acc[4 * g + 3] = bf2f(w.y >> 16); }
}
__device__ __forceinline__ f32x16 zero16() { f32x16 z;
#pragma unroll
    for (int r = 0; r < 16; ++r) z[r] = 0.f; return z; }
constexpr int OFF_KKD = 0, OFF_RD = 4608, OFF_BI = 9216, OFF_KI = 13824;
constexpr int OFF_KKDT = 18432, OFF_BIT = 23552, OFF_KIT = 28672, OFF_VT = 33792;
constexpr int OFF_P0 = 38912, OFF_P1 = 41472, OFF_PT0 = 44032, OFF_PT1 = 46592, OFF_X0 = 49152, OFF_X1 = 51712, OFF_AK = 54272, OFF_BRB = 56832, OFF_BRK = 59392;
constexpr int OFF_AKVT = 61952, OFF_GAM = 67072, SLOT = 67328;
constexpr int OFF_Q1 = OFF_KKD, OFF_G = OFF_BI, OFF_P1T = OFF_P0, OFF_P2T = OFF_P0 + 5120, OFF_YB = OFF_KKDT, OFF_WT = OFF_P0;
constexpr int OFF_M0 = 2 * SLOT, OFF_M1 = OFF_X0  , LDS_END = OFF_M0 + 9216;
static_assert(LDS_END <= LDS_BYTES - 64, "rwkv LDS map");
}

#define XB_TMO      128
#define XB_XCNT(j)  (256  + 64 * (j))
#define XB_XSUB(j)  (1280 + 64 * (j))
#define XB_XGEN(j)  (2304 + 64 * (j))
#define XB_TOP      3328
#define XB_TOPGEN   3392
#define XCD_BAR_WORDS 3456
#define XB_SPIN_CAP (1u << 18)
__device__ __forceinline__ unsigned xb_ld(unsigned* p)              { return __hip_atomic_load(p, __ATOMIC_RELAXED, __HIP_MEMORY_SCOPE_AGENT); }
__device__ __forceinline__ unsigned xb_add(unsigned* p, unsigned v) { return __hip_atomic_fetch_add(p, v, __ATOMIC_RELAXED, __HIP_MEMORY_SCOPE_AGENT); }
__device__ __forceinline__ unsigned xb_xcc_id() { return (unsigned)__builtin_amdgcn_s_getreg((3 << 11) | 20) & 0xFu; }
#define XB_SPIN(cond, bar) do { unsigned _sp = 0; while (cond) { __builtin_amdgcn_s_sleep(1); \
    if ((++_sp & 255u) == 0u) { if (xb_ld(&(bar)[XB_TMO])) break; if (_sp > XB_SPIN_CAP) { atomicAdd(&(bar)[XB_TMO], 1u); break; } } } } while (0)
struct XcdBarrier { unsigned* bar; unsigned x; volatile LAS unsigned* st; };
__device__ __forceinline__ XcdBarrier xcd_barrier_post(unsigned* bar, volatile LAS unsigned* st) {
    XcdBarrier b; b.bar = bar; b.x = xb_xcc_id(); b.st = st;
    if (threadIdx.x == 0) (void)xb_add(&bar[XB_XCNT(b.x)], 1u);
    return b;
}
__device__ __forceinline__ void xcd_barrier_complete(unsigned* bar, unsigned x, unsigned& nloc, unsigned& nx) {
    const unsigned G = gridDim.x * gridDim.y * gridDim.z;
    unsigned sum, cnt, mine, sp = 0u;
    for (;;) {
        sum = 0u; cnt = 0u; mine = 0u;
#pragma unroll
        for (unsigned j = 0; j < 16; ++j) { const unsigned c = xb_ld(&bar[XB_XCNT(j)]); sum += c; cnt += (c > 0u) ? 1u : 0u; mine = (j == x) ? c : mine; }
        if (sum == G) break;
        __builtin_amdgcn_s_sleep(1);
        if ((++sp & 255u) == 0u) { if (xb_ld(&bar[XB_TMO])) break; if (sp > XB_SPIN_CAP) { atomicAdd(&bar[XB_TMO], 1u); break; } }
    }
    nloc = mine > 0u ? mine : 1u; nx = cnt > 0u ? cnt : 1u;
}
__device__ __forceinline__ void xcd_barrier(const XcdBarrier& b, int wave_) {
    asm volatile("s_waitcnt vmcnt(0)" ::: "memory");
    __syncthreads();
    if (wave_ == 0 && __builtin_amdgcn_mbcnt_hi(~0u, __builtin_amdgcn_mbcnt_lo(~0u, 0u)) == 0) {
        unsigned* bar = b.bar;
        __builtin_amdgcn_s_waitcnt(0);
        unsigned nloc = b.st[0], nx = b.st[1];
        if (nloc == 0u) { xcd_barrier_complete(bar, b.x, nloc, nx); b.st[0] = nloc; b.st[1] = nx; }
        const unsigned old = xb_add(&bar[XB_XSUB(b.x)], 1u);
        const unsigned gen = old / nloc;
        if (old + 1u == (gen + 1u) * nloc) {
            __builtin_amdgcn_fence(__ATOMIC_RELEASE, "agent");
            asm volatile("s_waitcnt vmcnt(0)" ::: "memory");
            const unsigned og = xb_add(&bar[XB_TOP], 1u);
            const unsigned tg = og / nx;
            if (og + 1u == (tg + 1u) * nx) xb_add(&bar[XB_TOPGEN], 1u);
            else XB_SPIN(xb_ld(&bar[XB_TOPGEN]) == tg, bar);
            __builtin_amdgcn_fence(__ATOMIC_ACQUIRE, "agent");
            xb_add(&bar[XB_XGEN(b.x)], 1u);
            asm volatile("s_waitcnt vmcnt(0)" ::: "memory");
        } else {
            XB_SPIN(xb_ld(&bar[XB_XGEN(b.x)]) == gen, bar);
            __builtin_amdgcn_fence(__ATOMIC_ACQUIRE, "agent");
            asm volatile("s_waitcnt vmcnt(0)" ::: "memory");
        }
    }
    __syncthreads();
}
constexpr int CW_TICKET2 = 128;
constexpr int CW_TICKET = 64;
constexpr int CW_BAR = 4096;
constexpr int LDS_BARST = LDS_BYTES - 64;

#define PHASE_PTRS \
    const int G = gridDim.x, bid = blockIdx.x; const int gw = bid * NWAVES + wave, NGW = G * NWAVES; (void)gw; (void)NGW; (void)G; (void)bid; \
    const int lane = (int)__builtin_amdgcn_mbcnt_hi(~0u, __builtin_amdgcn_mbcnt_lo(~0u, 0u)); const int tid = wave * 64 + lane; (void)tid; \
    const __attribute__((address_space(4))) Args* A_ = (const __attribute__((address_space(4))) Args*)__builtin_amdgcn_kernarg_segment_ptr(); asm volatile("" : "+s"(A_)); \
    unsigned char* ws = A_->ws; const float* const __attribute__((address_space(4)))* AIN = A_->in; const float* x = AIN[0]; float* OUT = A_->out; \
    unsigned* ctl = (unsigned*)(ws + WS_CTL); unsigned* cnt = ctl; \
    int* ltok = (int*)(ws + WS_LTOK); int* ldst = (int*)(ws + WS_LDST); float* lgate = (float*)(ws + WS_LGATE); \
    bf16_t* XN = (bf16_t*)(ws + WS_XN); bf16_t* Y = (bf16_t*)(ws + WS_Y); bf16_t* H1 = (bf16_t*)(ws + WS_H1); \
    bf16_t* PROJ = (bf16_t*)(ws + WS_PROJ); \
    bf16_t *WIN = (bf16_t*)(ws + WS_WIN), *WOUT = (bf16_t*)(ws + WS_WOUT), *WDN = (bf16_t*)(ws + WS_WDN), *WUP = (bf16_t*)(ws + WS_WUP); \
    bf16_t *RR = (bf16_t*)(ws + WS_RR), *RK = (bf16_t*)(ws + WS_RK), *RV = (bf16_t*)(ws + WS_RV), *RKK = (bf16_t*)(ws + WS_RKK), *RB = (bf16_t*)(ws + WS_RB), *RG = (bf16_t*)(ws + WS_RG); \
    float* RWd = (float*)(ws + WS_RW); float* RKD = (float*)(ws + WS_RKD); bf16_t* REC = (bf16_t*)(ws + WS_REC); (void)REC; \
    bf16_t* OC = (bf16_t*)(ws + WS_OC); bf16_t* ACT = (bf16_t*)(ws + WS_ACT); bf16_t* YK = (bf16_t*)(ws + WS_YK); \
    (void)x; (void)OUT; (void)cnt; (void)ltok; (void)ldst; (void)lgate; (void)XN; (void)Y; (void)H1; (void)PROJ; (void)WIN; (void)WOUT; (void)WDN; (void)WUP; \
    (void)RR; (void)RK; (void)RV; (void)RKK; (void)RB; (void)RG; (void)RWd; (void)RKD; (void)OC; (void)ACT; (void)YK; (void)AIN;

__global__ void __launch_bounds__(NTHREADS, 2) mk_fwd(Args args) {
    extern __shared__ __attribute__((aligned(16))) unsigned char lds_raw[];
    LAS unsigned char* lds = (LAS unsigned char*)lds_raw;
    const int wave = __builtin_amdgcn_readfirstlane(threadIdx.x >> 6);
    unsigned* ctl = (unsigned*)(args.ws + WS_CTL);
    const int lo = args.ph_lo, hi = args.ph_hi;
    if (threadIdx.x < 16) ((LAS unsigned*)(lds + LDS_BARST))[threadIdx.x] = 0u;
    __syncthreads();
    XcdBarrier gbar; gbar.bar = ctl + CW_BAR; gbar.x = 0; gbar.st = (volatile LAS unsigned*)(lds + LDS_BARST);
    if (hi - lo > 1) gbar = xcd_barrier_post(ctl + CW_BAR, (volatile LAS unsigned*)(lds + LDS_BARST));
#define NEXT_TICKET(dst) do { __syncthreads(); if (threadIdx.x == 0) *(volatile LAS unsigned*)(lds + LDS_BYTES - 32) = xb_add(ctl + CW_TICKET, 1u); __syncthreads(); dst = (int)*(volatile LAS unsigned*)(lds + LDS_BYTES - 32); } while (0)
#define NEXT_TICKET2(dst) do { __syncthreads(); if (threadIdx.x == 0) *(volatile LAS unsigned*)(lds + LDS_BYTES - 32) = xb_add(ctl + CW_TICKET2, 1u); __syncthreads(); dst = (int)*(volatile LAS unsigned*)(lds + LDS_BYTES - 32); } while (0)
#define SEAM(k) do { if (lo <= (k) && (k) + 1 < hi) xcd_barrier(gbar, wave); } while (0)
#ifndef PHMASK
#define PHMASK 0xFFFF
#endif
#ifndef REPEAT_PH
#define REPEAT_PH -1
#endif
#define REP(k) for (int rep_ = 0; rep_ < ((REPEAT_PH == (k)) ? 2 : 1); ++rep_)
#define IN(k) (((PHMASK >> (k)) & 1) && lo <= (k) && (k) < hi)

    if (IN(0)) REP(0) {
        PHASE_PTRS
        float tmp[16];
        for (int m = gw; m < T; m += NGW) rms_row(x + (size_t)m * D, AIN[1], XN + (size_t)m * D, lane, tmp);
#if MFMA_GEMM
        {
            LAS float* scr = (LAS float*)(lds + wave * 16384);
            constexpr int I_IN = 16 * (INC / 32), I_OUT = 16 * (D / 32);
            constexpr int I_L = 16 + 16 + 32;
            constexpr int NIT = I_IN + I_OUT + I_L;
            for (int it = gw; it < NIT; it += NGW) {
                int r = it;
                if (r < I_IN) { transpose_item(AIN[2], D, INC, WIN, scr, r, lane); continue; } r -= I_IN;
                if (r < I_OUT) { transpose_item(AIN[19], D, D, WOUT, scr, r, lane); continue; } r -= I_OUT;
                if (r < 16) { transpose_item(AIN[5], 64, RW, (bf16_t*)(ws + WS_WBT), scr, r, lane); continue; } r -= 16;
                if (r < 16) { transpose_item(AIN[7], 64, RW, (bf16_t*)(ws + WS_ABT), scr, r, lane); continue; } r -= 16;
                transpose_item(AIN[8], 128, RW, (bf16_t*)(ws + WS_GBT), scr, r, lane);
            }
            { const int gt = bid * NTHREADS + tid;
              if (gt < D * NE) { const int k = gt >> 5, e = gt & 31; const float w = AIN[20][k] * AIN[21][gt];
                  const unsigned short h0 = (unsigned short)f2bf(w); const float r1 = w - bf2f(h0); const unsigned short h1 = (unsigned short)f2bf(r1); const float r2 = r1 - bf2f(h1); const unsigned short h2 = (unsigned short)f2bf(r2);
                  bf16_t* rws = (bf16_t*)(ws + WS_RWS); rws[(size_t)(0 * NE + e) * D + k] = h0; rws[(size_t)(1 * NE + e) * D + k] = h1; rws[(size_t)(2 * NE + e) * D + k] = h2; } }
        }
#endif
    }
#if MFMA_GEMM
    auto gemm_ph = [&](auto phc) {
        constexpr int ph = decltype(phc)::value;
        PHASE_PTRS
        LAS int* meta = (LAS int*)(lds + 131072);
        if (ph >= 8) {
            __syncthreads();
            if (tid < 32) {
                const int cn = (int)xb_ld(&cnt[tid]); const int nt_ = (cn + 255) / 256; int incl = nt_;
#pragma unroll
                for (int d = 1; d < 32; d <<= 1) { const int o = __shfl_up(incl, d, 32); if (tid >= d) incl += o; }
                meta[tid] = incl - nt_; meta[64 + tid] = (incl - nt_) * 256; meta[128 + tid] = cn; if (tid == NE - 1) meta[NE] = incl;
                for (int rt_ = incl - nt_; rt_ < incl; ++rt_) meta[256 + rt_] = tid; }
            __syncthreads();
        }
        if constexpr (ph == 1) { pg8::DenseOrder S; S.init(T, INC, G, bid); pg8::EpiProj E{PROJ}; pg8::gemm_phase<pg8::EpiProj, pg8::DenseOrder, pg8::RowDense, true, false>(lds, XN, WIN, S, pg8::RowDense{2048u}, E, wave, lane); }
        else if constexpr (ph == 6) { pg8::DenseOrder S; S.init(T, D, G, bid); pg8::EpiOut E{x, H1}; pg8::gemm_phase<pg8::EpiOut, pg8::DenseOrder, pg8::RowDense, true, false>(lds, Y, WOUT, S, pg8::RowDense{2048u}, E, wave, lane); }
        else if constexpr (ph == 8) { pg8::MoeOrder S{meta, 2 * DFF / 256, G, bid, meta[NE] * (2 * DFF / 256)}; pg8::EpiUp E{ACT, AIN[24], 1.f / 32.f};
            pg8::gemm_phase<pg8::EpiUp, pg8::MoeOrder, pg8::RowGather, true, true>(lds, XN, WUP, S, pg8::RowGather{ltok, 1024u}, E, wave, lane); }
        else { pg8::MoeOrder S{meta, D / 256, G, bid, meta[NE] * (D / 256)}; pg8::EpiDown E{YK, AIN[26], ldst, lgate, 1.f / 32.f};
            pg8::gemm_phase<pg8::EpiDown, pg8::MoeOrder, pg8::RowDense, true, true>(lds, ACT, WDN, S, pg8::RowDense{1024u}, E, wave, lane); }
    };
#else
    auto gemm_ph = [&](auto phc) {
        constexpr int ph = decltype(phc)::value;
        PHASE_PTRS
        LAS int* rowidx = (LAS int*)(lds + 2 * 16 * NG_LD * 4);
        LAS int* meta = rowidx + 128;
        const bool moe = ph >= 8;
        __syncthreads();
        if (moe && tid == 0) {
            int tp = 0, sb = 0;
            for (int e = 0; e < NE; ++e) { const int cn = (int)xb_ld(&cnt[e]); meta[e] = tp; meta[64 + e] = sb; meta[128 + e] = cn; tp += (cn + 127) / 128; sb += (cn + 255) / 256 * 256; }
            meta[NE] = tp;
        }
        __syncthreads();
        const int nrt = moe ? meta[NE] : T / 128;
        const int ncols = (ph == 1) ? INC : (ph == 8) ? 2 * DFF : D;
        const int nct = ncols / 128;
        const bf16_t* Ab = (ph == 1 || ph == 8) ? XN : (ph == 6) ? Y : ACT;
        for (int u = bid; u < nrt * nct; u += G) {
            const int rt = u / nct, ct = u % nct;
            int e = 0, r0 = rt * 128, cn = T, sb = 0;
            if (moe) { for (int q = 1; q < NE; ++q) if (meta[q] <= rt) e = q;
                       r0 = (rt - meta[e]) * 128; cn = meta[128 + e]; sb = meta[64 + e]; }
            __syncthreads();
            if (tid < 128) { const int r = r0 + tid; rowidx[tid] = (r < cn) ? (ph == 8 ? ltok[(size_t)e * T + r] : sb + r) : -1; }
            __syncthreads();
            const float* Wm = (ph == 1) ? AIN[2] : (ph == 6) ? AIN[19] : (ph == 8) ? AIN[23] + (size_t)e * D * 2 * DFF : AIN[25] + (size_t)e * DFF * D;
            const float* bias = (ph == 8) ? AIN[24] + (size_t)e * 2 * DFF : (ph == 9) ? AIN[26] + (size_t)e * D : nullptr;
            auto epi = [&](int r, int ri, int col, f32x4 v) {
                if (ri < 0) return;
                if (ph == 1) { u32x2 w; w.x = pk2(v.x, v.y); w.y = pk2(v.z, v.w); *(u32x2*)(PROJ + (size_t)ri * INC + col) = w; }
                else if (ph == 6) { const f32x4 xr = *(const f32x4*)(x + (size_t)ri * D + col); const f32x4 hv = xr + v; u32x2 w; w.x = pk2(hv.x, hv.y); w.y = pk2(hv.z, hv.w); *(u32x2*)(H1 + (size_t)ri * D + col) = w; }
                else if (ph == 8) {
                    const f32x4 bb = *(const f32x4*)(bias + col); v = v + bb;
                    const float g0 = fminf(v.x, 7.f), l0 = fminf(fmaxf(v.y, -7.f), 7.f), g1 = fminf(v.z, 7.f), l1 = fminf(fmaxf(v.w, -7.f), 7.f);
                    const float a0 = g0 * sigmoidf_(1.702f * g0) * (l0 + 1.f), a1 = g1 * sigmoidf_(1.702f * g1) * (l1 + 1.f);
                    *(unsigned*)(ACT + (size_t)(sb + r0 + r) * DFF + (col >> 1)) = pk2(a0, a1);
                } else {
                    const f32x4 bb = *(const f32x4*)(bias + col); const float gt = lgate[(size_t)e * T + r0 + r]; const int dst = ldst[(size_t)e * T + r0 + r];
                    v = (v + bb) * gt;
                    u32x2 w; w.x = pk2(v.x, v.y); w.y = pk2(v.z, v.w); *(u32x2*)(YK + (size_t)dst * D + col) = w;
                }
            };
            ngemm_unit(lds, Ab, 1024, Wm, ncols, ct * 128, epi);
        }
    };
#endif
    SEAM(0);
    if (IN(1) && (int)blockIdx.x >= (T / 256) * (INC / 256) - 6 * (int)gridDim.x && gridDim.x == 256) {
        PHASE_PTRS
        int cvt; NEXT_TICKET2(cvt);
        if (cvt < CV_TICKETS) convert_ticket(cvt, AIN[23], AIN[25], (unsigned char*)WUP, (unsigned char*)WDN, (LAS float*)(lds + wave * 16384), wave, lane);
        __syncthreads();
    }
    if (IN(1)) REP(1) gemm_ph(std::integral_constant<int, 1>{});
    SEAM(1);
    if (IN(2)) REP(2) {
        PHASE_PTRS
        typedef short bf16x8 __attribute__((ext_vector_type(8)));
        typedef float f32x16 __attribute__((ext_vector_type(16)));
        const float *mu = AIN[3], *w0 = AIN[4], *a0 = AIN[6], *kkw = AIN[9], *kaw = AIN[10], *rkw = AIN[11];
        const bf16_t *WBT = (const bf16_t*)(ws + WS_WBT), *ABT = (const bf16_t*)(ws + WS_ABT), *GBT = (const bf16_t*)(ws + WS_GBT);
        constexpr int TRS = 3600, LRS = 528, OFF_LO = 33 * TRS;
        const int r32 = lane & 31, hi = lane >> 5, h = wave;
        for (int it = bid; it < T / 32; it += G) {
            const int t0 = it * 32; const bool first = (t0 % SEQ) == 0;
            __syncthreads();
#pragma unroll
            for (int rb = 0; rb < 5; rb += 3) {
                u32x4 sv[3][4];
#pragma unroll
                for (int rr_ = 0; rr_ < 3; ++rr_) { const int row = wave + 8 * (rb + rr_);
#pragma unroll
                    for (int q = 0; q < 4; ++q) { const int c16 = lane + 64 * q; sv[rr_][q] = (u32x4){0u, 0u, 0u, 0u};
                        if (rb + rr_ < 5 && row < 33 && c16 < 224 && (row > 0 || !first)) sv[rr_][q] = *(const u32x4*)(PROJ + (size_t)(t0 - 1 + row) * INC + c16 * 8); } }
#pragma unroll
                for (int rr_ = 0; rr_ < 3; ++rr_) { const int row = wave + 8 * (rb + rr_);
#pragma unroll
                    for (int q = 0; q < 4; ++q) { const int c16 = lane + 64 * q;
                        if (rb + rr_ < 5 && row < 33 && c16 < 224) *(LAS u32x4*)(lds + row * TRS + c16 * 16) = sv[rr_][q]; } }
            }
            __syncthreads();
#pragma unroll 4
            for (int q = 0; q < 16; ++q) {
                const int j = tid & 255, tok = (tid >> 8) + 2 * q, col = 1536 + j;
                const float cur = bf2f(*(const LAS unsigned short*)(lds + (tok + 1) * TRS + col * 2)), prv = bf2f(*(const LAS unsigned short*)(lds + tok * TRS + col * 2));
                const float p = cur + (prv - cur) * mu[col];
                float f = p;
                if (__builtin_amdgcn_readfirstlane(j) < 64) { const float e2 = __expf(-2.f * fabsf(p)); f = copysignf((1.f - e2) * __builtin_amdgcn_rcpf(1.f + e2), p); }
                else if (__builtin_amdgcn_readfirstlane(j) >= 128) f = __builtin_amdgcn_rcpf(1.f + __expf(-p));
                *(LAS unsigned short*)(lds + OFF_LO + tok * LRS + j * 2) = (unsigned short)f2bf(f);
            }
            __syncthreads();
            f32x16 Wa[2], Aa[2], Ga[2];
#pragma unroll
            for (int ct = 0; ct < 2; ++ct) {
                const int col = 64 * h + 32 * ct + r32;
#pragma unroll
                for (int r = 0; r < 16; ++r) { Wa[ct][r] = 0.f; Aa[ct][r] = 0.f; Ga[ct][r] = 0.f; }
#pragma unroll
                for (int s4 = 0; s4 < 4; ++s4) {
                    const bf16x8 aw = *(const LAS bf16x8*)(lds + OFF_LO + r32 * LRS + (16 * s4 + 8 * hi) * 2), aa = *(const LAS bf16x8*)(lds + OFF_LO + r32 * LRS + (64 + 16 * s4 + 8 * hi) * 2);
                    const bf16x8 bw = *(const bf16x8*)(WBT + (size_t)col * 64 + 16 * s4 + 8 * hi), ba = *(const bf16x8*)(ABT + (size_t)col * 64 + 16 * s4 + 8 * hi);
                    Wa[ct] = __builtin_amdgcn_mfma_f32_32x32x16_bf16(aw, bw, Wa[ct], 0, 0, 0);
                    Aa[ct] = __builtin_amdgcn_mfma_f32_32x32x16_bf16(aa, ba, Aa[ct], 0, 0, 0);
                }
#pragma unroll
                for (int s8 = 0; s8 < 8; ++s8) {
                    const bf16x8 ag = *(const LAS bf16x8*)(lds + OFF_LO + r32 * LRS + (128 + 16 * s8 + 8 * hi) * 2);
                    const bf16x8 bg = *(const bf16x8*)(GBT + (size_t)col * 128 + 16 * s8 + 8 * hi);
                    Ga[ct] = __builtin_amdgcn_mfma_f32_32x32x16_bf16(ag, bg, Ga[ct], 0, 0, 0);
                }
            }
            float cmu[2][3], cw0[2], ca0[2], ckk[2], cka[2], crk[2];
#pragma unroll
            for (int ct = 0; ct < 2; ++ct) { const int c = 64 * h + 32 * ct + r32;
                cmu[ct][0] = mu[c]; cmu[ct][1] = mu[512 + c]; cmu[ct][2] = mu[1024 + c]; cw0[ct] = w0[c]; ca0[ct] = a0[c]; ckk[ct] = kkw[c]; cka[ct] = kaw[c]; crk[ct] = rkw[c]; }
#pragma unroll
            for (int r = 0; r < 16; ++r) {
                const int i = (r & 3) + 8 * (r >> 2) + 4 * hi; const size_t t = (size_t)t0 + i;
                float rr[2], k2[2], vv[2], kkv[2], av[2], dec[2];
                float n2 = 0.f, rkd = 0.f;
#pragma unroll
                for (int ct = 0; ct < 2; ++ct) {
                    const int c = 64 * h + 32 * ct + r32;
                    const LAS unsigned char* pc = lds + (i + 1) * TRS + c * 2; const LAS unsigned char* pp = lds + i * TRS + c * 2;
                    const float rc = bf2f(*(const LAS unsigned short*)pc), kc = bf2f(*(const LAS unsigned short*)(pc + 1024)), vc = bf2f(*(const LAS unsigned short*)(pc + 2048));
                    const float rp = bf2f(*(const LAS unsigned short*)pp), kp = bf2f(*(const LAS unsigned short*)(pp + 1024)), vp = bf2f(*(const LAS unsigned short*)(pp + 2048));
                    rr[ct] = rc + (rp - rc) * cmu[ct][0]; const float k = kc + (kp - kc) * cmu[ct][1]; vv[ct] = vc + (vp - vc) * cmu[ct][2];
                    const float wraw = cw0[ct] + Wa[ct][r];
                    dec[ct] = -0.6065306597126334f * __builtin_amdgcn_rcpf(1.f + __expf(-wraw));
                    av[ct] = __builtin_amdgcn_rcpf(1.f + __expf(-(ca0[ct] + Aa[ct][r])));
                    kkv[ct] = k * ckk[ct]; n2 += kkv[ct] * kkv[ct];
                    k2[ct] = k * (1.f + (av[ct] - 1.f) * cka[ct]);
                    rkd += rr[ct] * k2[ct] * crk[ct];
                }
                n2 += dpp_f<0xB1>(n2); rkd += dpp_f<0xB1>(rkd); n2 += dpp_f<0x4E>(n2); rkd += dpp_f<0x4E>(rkd);
                n2 += dpp_f<0x141>(n2); rkd += dpp_f<0x141>(rkd); n2 += dpp_f<0x140>(n2); rkd += dpp_f<0x140>(rkd);
                n2 += __shfl_xor(n2, 16); rkd += __shfl_xor(rkd, 16);
                const float inorm = __builtin_amdgcn_rsqf(fmaxf(n2, 1e-24f));
#pragma unroll
                for (int ct = 0; ct < 2; ++ct) {
                    const size_t o = t * RW + 64 * h + 32 * ct + r32;
                    const float kkn = kkv[ct] * inorm;
                    u32x4 rec; rec.x = pk2(rr[ct], k2[ct]); rec.y = pk2(vv[ct], kkn); rec.z = pk2(kkn * av[ct], Ga[ct][r]); rec.w = pk2(dec[ct], 0.f);
                    *(u32x4*)(REC + o * 8) = rec;
                }
                if (r32 == 0) RKD[t * NRH + h] = rkd;
            }
        }
    }
    SEAM(2);
    int q_ticket = 0;
    if (IN(3)) REP(3) {
        PHASE_PTRS
        using namespace rk;
        const float *lng = AIN[12], *lnb = AIN[13];
        int r32 = lane & 31, hi = lane >> 5;
#define OPQ() asm volatile("" : "+v"(r32), "+v"(hi))
        const int sl = wave >> 2, wq = wave & 3;
        int slv = sl * SLOT; asm volatile("" : "+v"(slv));
        LAS unsigned char* const LS = lds + slv;
        for (;;) {
            NEXT_TICKET(q_ticket);
            if (q_ticket >= NB * NRH) break;
            const int item = q_ticket;
            const int b = item / NRH, h = item % NRH;
            const size_t tb = (size_t)b * SEQ;
            f32x16 Macc = zero16(), XT = zero16(), HA = zero16(), HB = zero16();
            __syncthreads();
            for (int i = tid; i < 9216 / 4; i += NTHREADS) ((LAS unsigned*)(lds + OFF_M0))[i] = 0u;
            const size_t cb = (size_t)h * 64 + lane;
            float pf_rkd[8]; u32x4 pf[8];
            auto prefetch = [&](size_t t0n) {
#pragma unroll
                for (int e = 0; e < 8; ++e) { const size_t t = t0n + (e >> 2) * 32 + 4 * wave + (e & 3);
                    pf[e] = *(const u32x4*)(REC + (t * RW + cb) * 8); pf_rkd[e] = RKD[t * NRH + h]; }
            };
            prefetch(tb);
            for (int cp = 0; cp < SEQ / 64; ++cp) {
                const size_t t0 = tb + (size_t)cp * 64;
                float lcum[8], lw[8];
#pragma unroll
                for (int s2 = 0; s2 < 2; ++s2) { float run = 0.f;
#pragma unroll
                  for (int e = 0; e < 4; ++e) { lw[4 * s2 + e] = bf2f(pf[4 * s2 + e].w & 0xffff); run += lw[4 * s2 + e]; lcum[4 * s2 + e] = run; }
                  ((LAS float*)(lds + s2 * SLOT + OFF_WT))[wave * 64 + lane] = run; }
                __syncthreads();
                unsigned cur_vg[8]; float cur_rkd[8];
#pragma unroll
                for (int s2 = 0; s2 < 2; ++s2) {
                    LAS unsigned char* L = lds + s2 * SLOT;
                    float base = 0.f, tot = 0.f;
#pragma unroll
                    for (int w2 = 0; w2 < 8; ++w2) { const float x = ((const LAS float*)(L + OFF_WT))[w2 * 64 + lane]; if (w2 < wave) base += x; tot += x; }
                    float kkd[4], rd[4], bi[4], ki[4];
#pragma unroll
                    for (int e = 0; e < 4; ++e) { const int q = 4 * s2 + e;
                        const float Lc = base + lcum[q];
                        const float gm1 = __expf(Lc - lw[q]), g = __expf(Lc), gi = __expf(-Lc);
                        kkd[e] = bf2f(pf[q].y >> 16) * gm1; rd[e] = bf2f(pf[q].x & 0xffff) * g; bi[e] = bf2f(pf[q].z & 0xffff) * gi; ki[e] = bf2f(pf[q].x >> 16) * gi;
                        cur_vg[q] = (pf[q].y & 0xffff) | (pf[q].z & 0xffff0000u); cur_rkd[q] = pf_rkd[q]; }
                    asm volatile("" ::: "memory");
                    {
#pragma unroll
                      for (int e = 0; e < 4; ++e) { const int ro = (4 * wave + e) * RS64 + 2 * lane;
                        *(LAS unsigned short*)(L + OFF_KKD + ro) = (unsigned short)(hpk(kkd[e], 0.f)); *(LAS unsigned short*)(L + OFF_RD + ro) = (unsigned short)(hpk(rd[e], 0.f));
                        *(LAS unsigned short*)(L + OFF_BI + ro) = (unsigned short)(hpk(bi[e], 0.f)); *(LAS unsigned short*)(L + OFF_KI + ro) = (unsigned short)(hpk(ki[e], 0.f)); } }
                    const int to = lane * RS32 + 8 * wave;
                    { u32x2 w; w.x = hpk(kkd[0], kkd[1]); w.y = hpk(kkd[2], kkd[3]); *(LAS u32x2*)(L + OFF_KKDT + to) = w; }
                    { u32x2 w; w.x = hpk(bi[0], bi[1]); w.y = hpk(bi[2], bi[3]); *(LAS u32x2*)(L + OFF_BIT + to) = w; }
                    { u32x2 w; w.x = hpk(ki[0], ki[1]); w.y = hpk(ki[2], ki[3]); *(LAS u32x2*)(L + OFF_KIT + to) = w; }
                    { u32x2 w; w.x = (pf[4 * s2].y & 0xffff) | (pf[4 * s2 + 1].y << 16); w.y = (pf[4 * s2 + 2].y & 0xffff) | (pf[4 * s2 + 3].y << 16); *(LAS u32x2*)(L + OFF_VT + to) = w; }
                    if (wave == 7) ((LAS float*)(L + OFF_GAM))[lane] = __expf(tot);
                }
                if (cp + 1 < SEQ / 64) prefetch(t0 + 64);
                __syncthreads(); OPQ();
                if (wq == 0) {
                    f32x16 a = zero16(); mm<4, false>(a, LS + OFF_KKD, RS64, 0, LS + OFF_BI, RS64, 0, r32, hi);
#pragma unroll
                    for (int r = 0; r < 16; ++r) { const int row = (r & 3) + 8 * (r >> 2) + 4 * hi; a[r] = (r32 < row) ? -a[r] : 0.f; }
                    tstore(a, LS + OFF_PT0, RS32, 0, 0, r32, hi);
                } else if (wq == 1) {
                    f32x16 a = zero16(); mm<4, false>(a, LS + OFF_BI, RS64, 0, LS + OFF_KKD, RS64, 0, r32, hi);
#pragma unroll
                    for (int r = 0; r < 16; ++r) { const int row = (r & 3) + 8 * (r >> 2) + 4 * hi; a[r] = (row < r32) ? -a[r] : 0.f; }
                    tstore(a, LS + OFF_P0, RS32, 0, 0, r32, hi);
#pragma unroll
                    for (int r = 0; r < 16; ++r) { const int row = (r & 3) + 8 * (r >> 2) + 4 * hi; XT[r] = a[r] + ((row == r32) ? 1.f : 0.f); }
                    tstore(XT, LS + OFF_X0, RS32, 0, 0, r32, hi);
                } else if (wq == 2) {
                    f32x16 a = zero16(); mm<4, false>(a, LS + OFF_KI, RS64, 0, LS + OFF_KKD, RS64, 0, r32, hi);
#pragma unroll
                    for (int r = 0; r < 16; ++r) { const int row = (r & 3) + 8 * (r >> 2) + 4 * hi; a[r] = (row < r32) ? a[r] : 0.f; }
                    tstore(a, LS + OFF_AK, RS32, 0, 0, r32, hi);
                } else {
                    f32x16 a = zero16(); mm<4, false>(a, LS + OFF_BI, RS64, 0, LS + OFF_RD, RS64, 0, r32, hi);
#pragma unroll
                    for (int r = 0; r < 16; ++r) { const int row = (r & 3) + 8 * (r >> 2) + 4 * hi; a[r] = (row <= r32) ? a[r] : 0.f; }
                    tstore(a, LS + OFF_BRB, RS32, 0, 0, r32, hi);
                }
                __syncthreads(); OPQ();
                if (wq == 0) { f32x16 a = zero16(); mm<2, false>(a, LS + OFF_P0, RS32, 0, LS + OFF_PT0, RS32, 0, r32, hi); tstore(a, LS + OFF_PT1, RS32, 0, 0, r32, hi); }
                else if (wq == 2) { f32x16 a = zero16(); mm<2, false>(a, LS + OFF_PT0, RS32, 0, LS + OFF_P0, RS32, 0, r32, hi); tstore(a, LS + OFF_P1, RS32, 0, 0, r32, hi); }
                else { const int vh = wq >> 1; f32x16 a = zero16(); mm<2, false>(a, LS + OFF_AK, RS32, 0, LS + OFF_VT, RS32, 32 * vh, r32, hi); tstore(a, LS + OFF_AKVT, RS32, 32 * vh, 0, r32, hi); }
                __syncthreads(); OPQ();
                if (wq == 0) { f32x16 a = zero16(); mm<2, false>(a, LS + OFF_P1, RS32, 0, LS + OFF_PT1, RS32, 0, r32, hi); tstore(a, LS + OFF_PT0, RS32, 0, 0, r32, hi); }
                else if (wq == 2) { f32x16 a = zero16(); mm<2, false>(a, LS + OFF_PT1, RS32, 0, LS + OFF_P1, RS32, 0, r32, hi); tstore(a, LS + OFF_P0, RS32, 0, 0, r32, hi); }
                else if (wq == 1) { mm<2, false>(XT, LS + OFF_PT1, RS32, 0, LS + OFF_X0, RS32, 0, r32, hi); tstore(XT, LS + OFF_X1, RS32, 0, 0, r32, hi); }
                __syncthreads(); OPQ();
                if (wq == 0) { f32x16 a = zero16(); mm<2, false>(a, LS + OFF_P0, RS32, 0, LS + OFF_PT0, RS32, 0, r32, hi); tstore(a, LS + OFF_PT1, RS32, 0, 0, r32, hi); }
                else if (wq == 2) { f32x16 a = zero16(); mm<2, false>(a, LS + OFF_PT0, RS32, 0, LS + OFF_P0, RS32, 0, r32, hi); tstore(a, LS + OFF_P1, RS32, 0, 0, r32, hi); }
                else if (wq == 1) { mm<2, false>(XT, LS + OFF_PT0, RS32, 0, LS + OFF_X1, RS32, 0, r32, hi); tstore(XT, LS + OFF_X0, RS32, 0, 0, r32, hi); }
                __syncthreads(); OPQ();
                if (wq == 0) { f32x16 a = zero16(); mm<2, false>(a, LS + OFF_P1, RS32, 0, LS + OFF_PT1, RS32, 0, r32, hi); tstore(a, LS + OFF_PT0, RS32, 0, 0, r32, hi); }
                else if (wq == 1) { mm<2, false>(XT, LS + OFF_PT1, RS32, 0, LS + OFF_X0, RS32, 0, r32, hi); tstore(XT, LS + OFF_X1, RS32, 0, 0, r32, hi); }
                else if (wq == 3) { f32x16 a = zero16(); mm<4, false>(a, LS + OFF_KI, RS64, 0, LS + OFF_RD, RS64, 0, r32, hi);
#pragma unroll
                    for (int r = 0; r < 16; ++r) { const int row = (r & 3) + 8 * (r >> 2) + 4 * hi; a[r] = (row <= r32) ? a[r] : 0.f; }
                    tstore(a, LS + OFF_BRK, RS32, 0, 0, r32, hi); }
                __syncthreads(); OPQ();
                if (wq == 1) { mm<2, false>(XT, LS + OFF_PT0, RS32, 0, LS + OFF_X1, RS32, 0, r32, hi); tstore(XT, LS + OFF_X0, RS32, 0, 0, r32, hi); }
                __syncthreads(); OPQ();
                if (wq < 2) { f32x16 a = zero16(); mm<2, false>(a, LS + OFF_X0, RS32, 0, LS + OFF_KKDT, RS32, 32 * wq, r32, hi); tstore(a, LS + OFF_P1T, RS32, 32 * wq, 0, r32, hi); }
                else { const int vh = wq - 2; f32x16 a = zero16(); mm<2, false>(a, LS + OFF_X0, RS32, 0, LS + OFF_AKVT, RS32, 32 * vh, r32, hi); tstore(a, LS + OFF_P2T, RS32, 32 * vh, 0, r32, hi); }
                __syncthreads(); OPQ();
#pragma unroll
                for (int s2 = 0; s2 < 2; ++s2) {
                    OPQ();
                    LAS unsigned char* L = lds + s2 * SLOT;
                    f32x16& HX = s2 ? HB : HA;
                    if (wave < 4) {
                        const int kh = wave >> 1, vh = wave & 1;
                        HX = zero16();
                        mm<2, false>(HX, L + OFF_KIT, RS32, 32 * kh, L + OFF_VT, RS32, 32 * vh, r32, hi);
                        mm<2, true>(HX, L + OFF_BIT, RS32, 32 * kh, L + OFF_P2T, RS32, 32 * vh, r32, hi);
                        f32x16 a = zero16(); mm<2, false>(a, L + OFF_P1T, RS32, 32 * kh, L + OFF_BIT, RS32, 32 * vh, r32, hi);
                        const float gmc = -((const LAS float*)(L + OFF_GAM))[32 * vh + r32];
#pragma unroll
                        for (int r = 0; r < 16; ++r) a[r] *= gmc;
                        tstore(a, L + OFF_G, RS64, 32 * vh, 32 * kh, r32, hi);
                    } else if (wave < 6) {
                        const int vh = wave - 4;
                        HX = zero16();
                        mm<2, false>(HX, L + OFF_BRK, RS32, 0, L + OFF_VT, RS32, 32 * vh, r32, hi);
                        mm<2, true>(HX, L + OFF_BRB, RS32, 0, L + OFF_P2T, RS32, 32 * vh, r32, hi);
                    } else {
                        const int kh = wave - 6;
                        f32x16 a = zero16(); mm<2, false>(a, L + OFF_P1T, RS32, 32 * kh, L + OFF_BRB, RS32, 0, r32, hi);
                        f32x16 q; tload(q, L + OFF_RD, RS64, 0, 32 * kh, r32, hi);
#pragma unroll
                        for (int r = 0; r < 16; ++r) q[r] -= a[r];
                        tstore(q, L + OFF_Q1, RS64, 0, 32 * kh, r32, hi);
                    }
                }
                __syncthreads(); OPQ();
#pragma unroll
                for (int s2 = 0; s2 < 2; ++s2) {
                    LAS unsigned char* L = lds + s2 * SLOT;
                    LAS unsigned char* Mold = lds + (s2 ? OFF_M1 : OFF_M0); LAS unsigned char* Mnew = lds + (s2 ? OFF_M0 : OFF_M1);
                    f32x16& HX = s2 ? HB : HA;
                    if (wave < 4) {
                        const int kh = wave >> 1, vh = wave & 1;
                        const LAS float* gam = (const LAS float*)(L + OFF_GAM);
#pragma unroll
                        for (int r = 0; r < 16; ++r) Macc[r] = gam[32 * kh + (r & 3) + 8 * (r >> 2) + 4 * hi] * (Macc[r] + HX[r]);
                        mm<4, false>(Macc, L + OFF_G, RS64, 32 * kh, Mold, RS64, 32 * vh, r32, hi);
                        tstore(Macc, Mnew, RS64, 32 * vh, 32 * kh, r32, hi);
                    } else if (wave < 6) {
                        const int vh = wave - 4;
                        mm<4, false>(HX, L + OFF_Q1, RS64, 0, Mold, RS64, 32 * vh, r32, hi);
                        LAS float* yb = (LAS float*)(L + OFF_YB);
#pragma unroll
                        for (int r = 0; r < 16; ++r) yb[((r & 3) + 8 * (r >> 2) + 4 * hi) * 64 + 32 * vh + r32] = HX[r];
                    }
                    __syncthreads(); OPQ();
                }
                {
                    const int cc = h * 64 + lane;
                    const float g_ln = lng[cc], b_ln = lnb[cc];
#pragma unroll
                    for (int q = 0; q < 8; ++q) {
                        const int i = 4 * wave + (q & 3); const size_t t = t0 + (q >> 2) * 32 + i;
                        const float y = ((const LAS float*)(lds + (q >> 2) * SLOT + OFF_YB))[i * 64 + lane];
                        const float mean = wave_sum(y) * (1.f / 64.f); const float d = y - mean;
                        const float var = wave_sum(d * d) * (1.f / 64.f);
                        float yn = d * rsqrtf(var + 64e-5f) * g_ln + b_ln;
                        yn += cur_rkd[q] * bf2f(cur_vg[q] & 0xffff);
                        yn *= bf2f(cur_vg[q] >> 16);
                        Y[t * D + cc] = (bf16_t)f2bf(yn);
                    }
                }
                __syncthreads();
            }
        }
    }
#undef OPQ
    if (IN(4)) {
        PHASE_PTRS
        if (!IN(3)) NEXT_TICKET(q_ticket);
        LAS float* scr = (LAS float*)(lds + wave * 16384);
        int cvt; NEXT_TICKET2(cvt);
        while (cvt < CV_TICKETS) { convert_ticket(cvt, AIN[23], AIN[25], (unsigned char*)WUP, (unsigned char*)WDN, scr, wave, lane); NEXT_TICKET2(cvt); }
    }
    if (IN(4)) REP(4) {
        PHASE_PTRS
        typedef short bf16x8 __attribute__((ext_vector_type(8)));
        typedef float f32x16 __attribute__((ext_vector_type(16)));
        typedef short s16x4 __attribute__((ext_vector_type(4)));
        constexpr int KBUF = 64 * 128, VBUF = 64 * 256;
        LAS unsigned char* Kb = lds; LAS unsigned char* Vb = lds + 6 * KBUF; LAS unsigned* stash = (LAS unsigned*)(lds + 6 * KBUF + 6 * VBUF);
        const float l1 = wave_sum(AIN[14][lane] * AIN[15][lane]), l2 = wave_sum(AIN[16][lane] * AIN[17][lane]);
        const float lam = __expf(l1) - __expf(l2) + 0.2f;
        const float* sg = AIN[18];
        for (; q_ticket < NB * NRH + NB * NDH * 8; ) {
            { const int idx = q_ticket - NB * NRH; const int qb = 7 - (idx >> 6), b = (idx & 63) >> 2, h = idx & 3;
            const float slope2 = exp2f(-8.f * (h + 1) / 4.f) * 1.4426950408889634f;
            {
                const int q0 = qb * 256, qw = q0 + 32 * wave;
                const int NT = 4 * (qb + 1);
                f32x16 o[4];
                for (int c = 0; c < 2; ++c) {
                    int tid_o = tid; asm volatile("" : "+v"(tid_o));
                    const int tid = tid_o, lane = tid & 63, r32 = lane & 31, hi = lane >> 5;
                    const int qpos = qw + r32;
                    const int ksw = (r32 >> 1) & 7, q4 = (lane & 15) >> 2;
                    const int vof0 = (4 * hi + q4) * 256 + (16 * ((lane >> 4) & 1) + 4 * (lane & 3)) * 2;
                    bf16x8 qf[4];
                    { const bf16_t* qp = PROJ + ((size_t)b * SEQ + qpos) * INC + RCOLS + h * 128 + c * 64 + hi * 8;
#pragma unroll
                      for (int s4 = 0; s4 < 4; ++s4) { const u32x4 raw = *(const u32x4*)(qp + s4 * 16); u32x4 w;
                          const float C2 = 0.125f * 1.4426950408889634f;
                          w.x = pk2(bf2f(raw.x & 0xffff) * C2, bf2f(raw.x >> 16) * C2); w.y = pk2(bf2f(raw.y & 0xffff) * C2, bf2f(raw.y >> 16) * C2);
                          w.z = pk2(bf2f(raw.z & 0xffff) * C2, bf2f(raw.z >> 16) * C2); w.w = pk2(bf2f(raw.w & 0xffff) * C2, bf2f(raw.w >> 16) * C2);
                          qf[s4] = __builtin_bit_cast(bf16x8, w); } }
#pragma unroll
                    for (int dt = 0; dt < 4; ++dt)
#pragma unroll
                        for (int r = 0; r < 16; ++r) o[dt][r] = 0.f;
                    float m = -1e30f, lsum = 0.f;
                    const int krow = 8 * wave + (lane >> 3), kch = (lane & 7) ^ ((krow >> 1) & 7);
                    const unsigned kgo = (unsigned)((b * SEQ + krow) * INC + RCOLS + 512 + h * 128 + c * 64 + kch * 8);
                    const int vrow0 = 4 * wave + (lane >> 4), vc16 = ((((lane & 15) >> 2) ^ (vrow0 & 3)) << 2) | (lane & 3);
                    const unsigned vgo = (unsigned)((b * SEQ + vrow0) * INC + RCOLS + 1024 + h * 128 + vc16 * 8);
#define ATT_ISSUE(tile) do { const unsigned go_ = (unsigned)(tile) * 64u * INC; const int sl_ = (tile) % 6; \
        __builtin_amdgcn_global_load_lds((const unsigned*)(PROJ + kgo + go_), (LAS unsigned*)(Kb + sl_ * KBUF + wave * 1024), 16, 0, 0); \
        __builtin_amdgcn_global_load_lds((const unsigned*)(PROJ + vgo + go_), (LAS unsigned*)(Vb + sl_ * VBUF + wave * 1024), 16, 0, 0); \
        __builtin_amdgcn_global_load_lds((const unsigned*)(PROJ + vgo + go_ + 32u * INC), (LAS unsigned*)(Vb + sl_ * VBUF + (wave + 8) * 1024), 16, 0, 0); } while (0)
                    __syncthreads();
                    ATT_ISSUE(0); ATT_ISSUE(1); ATT_ISSUE(2); ATT_ISSUE(3);
                    for (int stp = 0; stp < NT / 2; ++stp) {
                        if (stp + 1 < NT / 2) asm volatile("s_waitcnt vmcnt(6)" ::: "memory"); else asm volatile("s_waitcnt vmcnt(0)" ::: "memory");
                        __builtin_amdgcn_s_barrier();
                        asm volatile("" ::: "memory");
                        if (stp + 2 < NT / 2) { ATT_ISSUE(2 * stp + 4); ATT_ISSUE(2 * stp + 5); }
                      for (int sub = 0; sub < 2; ++sub) {
                        const int tt = 2 * stp + sub, rs3 = tt % 6;
                        if (tt * 64 > qw + 31) continue;
                        const LAS unsigned char* kb = Kb + rs3 * KBUF;
                        f32x16 p0, p1;
#pragma unroll
                        for (int r = 0; r < 16; ++r) { p0[r] = 0.f; p1[r] = 0.f; }
#pragma unroll
                        for (int s4 = 0; s4 < 4; ++s4) {
                            const int ko = r32 * 128 + (((2 * s4 + hi) ^ ksw) * 16); const bf16x8 k0 = *(const LAS bf16x8*)(kb + ko), k1 = *(const LAS bf16x8*)(kb + ko + 32 * 128);
                            p0 = __builtin_amdgcn_mfma_f32_32x32x16_bf16(k0, qf[s4], p0, 0, 0, 0);
                            p1 = __builtin_amdgcn_mfma_f32_32x32x16_bf16(k1, qf[s4], p1, 0, 0, 0);
                        }
                        const float tbias = slope2 * (float)(tt * 64 + 4 * hi - q0);
                        const bool band = (tt * 64 + 63 > qw);
                        float mx0 = -INFINITY, mx1 = -INFINITY;
#pragma unroll
                        for (int r = 0; r < 16; ++r) {
                            const float br = tbias + slope2 * (float)((r & 3) + 8 * (r >> 2));
                            p0[r] += br; p1[r] += br + 32.f * slope2;
                        }
                        if (__builtin_amdgcn_readfirstlane((int)band)) {
                            asm volatile("; causal band tile" ::: "memory");
                            const int kb0 = tt * 64 + 4 * hi;
#pragma unroll
                            for (int r = 0; r < 16; ++r) { const int kp = kb0 + (r & 3) + 8 * (r >> 2); if (kp > qpos) p0[r] = -INFINITY; if (kp + 32 > qpos) p1[r] = -INFINITY; }
                            asm volatile("" : "+v"(p0), "+v"(p1));
                        }
#pragma unroll
                        for (int r = 0; r < 16; r += 2) { mx0 = __builtin_fmaxf(__builtin_fmaxf(mx0, p0[r]), p0[r + 1]); mx1 = __builtin_fmaxf(__builtin_fmaxf(mx1, p1[r]), p1[r + 1]); }
                        float mx = __builtin_fmaxf(mx0, mx1);
                        { auto sw = __builtin_amdgcn_permlane32_swap(__float_as_uint(mx), __float_as_uint(mx), false, false); mx = __builtin_fmaxf(__uint_as_float(sw[0]), __uint_as_float(sw[1])); }
                        const float mn = __builtin_fmaxf(m, mx);
                        if (__any(mn > m)) {
                            const float sc = __builtin_amdgcn_exp2f(m - mn); lsum *= sc;
#pragma unroll
                            for (int dt = 0; dt < 4; ++dt)
#pragma unroll
                                for (int r = 0; r < 16; ++r) o[dt][r] *= sc;
                            m = mn;
                        }
                        float ps0 = 0.f, ps1 = 0.f;
#pragma unroll
                        for (int r = 0; r < 16; ++r) { p0[r] = __builtin_amdgcn_exp2f(p0[r] - m); p1[r] = __builtin_amdgcn_exp2f(p1[r] - m); ps0 += p0[r]; ps1 += p1[r]; }
                        lsum += ps0 + ps1;
                        bf16x8 pb[4];
#pragma unroll
                        for (int ks = 0; ks < 4; ++ks) { u32x4 w;
                            if (ks < 2) { const int r8 = 8 * ks; w.x = pk2(p0[r8], p0[r8 + 1]); w.y = pk2(p0[r8 + 2], p0[r8 + 3]); w.z = pk2(p0[r8 + 4], p0[r8 + 5]); w.w = pk2(p0[r8 + 6], p0[r8 + 7]); }
                            else { const int r8 = 8 * (ks - 2); w.x = pk2(p1[r8], p1[r8 + 1]); w.y = pk2(p1[r8 + 2], p1[r8 + 3]); w.z = pk2(p1[r8 + 4], p1[r8 + 5]); w.w = pk2(p1[r8 + 6], p1[r8 + 7]); }
                            pb[ks] = __builtin_bit_cast(bf16x8, w); }
                        const unsigned vbase = (unsigned)(uintptr_t)(Vb + rs3 * VBUF);
#pragma unroll
                        for (int dt = 0; dt < 4; ++dt) {
                            const unsigned va = vbase + (unsigned)(vof0 + ((dt ^ q4) * 64));
                            s16x4 f0[4], f1[4];
#pragma unroll
                            for (int ks = 0; ks < 4; ++ks) {
                                asm volatile("ds_read_b64_tr_b16 %0, %1 offset:%c2" : "=&v"(f0[ks]) : "v"(va), "i"(ks * 4096) : "memory");
                                asm volatile("ds_read_b64_tr_b16 %0, %1 offset:%c2" : "=&v"(f1[ks]) : "v"(va), "i"(ks * 4096 + 2048) : "memory");
                            }
                            asm volatile("s_waitcnt lgkmcnt(0)" ::: "memory"); __builtin_amdgcn_sched_barrier(0);
#pragma unroll
                            for (int ks = 0; ks < 4; ++ks) {
                                const bf16x8 av = {f0[ks][0], f0[ks][1], f0[ks][2], f0[ks][3], f1[ks][0], f1[ks][1], f1[ks][2], f1[ks][3]};
                                o[dt] = __builtin_amdgcn_mfma_f32_32x32x16_bf16(av, pb[ks], o[dt], 0, 0, 0);
                            }
                        }
                      }
                    }
                    lsum += __shfl_xor(lsum, 32);
                    const float il = 1.f / lsum;
                    u32x4* stq = (u32x4*)OC + (size_t)bid * 8 * NTHREADS + tid;
                    if (c == 0) {
#pragma unroll
                        for (int dt = 0; dt < 4; ++dt)
#pragma unroll
                            for (int rg = 0; rg < 2; ++rg) { u32x4 w; const int r = 8 * rg;
                                w.x = pk2(o[dt][r] * il, o[dt][r + 1] * il); w.y = pk2(o[dt][r + 2] * il, o[dt][r + 3] * il); w.z = pk2(o[dt][r + 4] * il, o[dt][r + 5] * il); w.w = pk2(o[dt][r + 6] * il, o[dt][r + 7] * il);
                                stq[(dt * 2 + rg) * NTHREADS] = w; }
                    } else {
                        float ss = 0.f;
#pragma unroll
                        for (int dt = 0; dt < 4; ++dt)
#pragma unroll
                            for (int rg = 0; rg < 2; ++rg) { const u32x4 w4 = stq[(dt * 2 + rg) * NTHREADS];
#pragma unroll
                                for (int j = 0; j < 4; ++j) { const int r = 8 * rg + 2 * j; const unsigned w = j == 0 ? w4.x : j == 1 ? w4.y : j == 2 ? w4.z : w4.w;
                                const float d0 = bf2f(w & 0xffff) - lam * o[dt][r] * il, d1 = bf2f(w >> 16) - lam * o[dt][r + 1] * il;
                                o[dt][r] = d0; o[dt][r + 1] = d1; ss += d0 * d0 + d1 * d1; } }
                        ss += __shfl_xor(ss, 32);
                        const float inv = rsqrtf(ss * (1.f / 128.f) + 1e-5f) * 0.8f;
                        bf16_t* yp = Y + ((size_t)b * SEQ + qpos) * D + 512 + h * 128 + 8 * hi;
#pragma unroll
                        for (int dt = 0; dt < 4; ++dt)
#pragma unroll
                            for (int p = 0; p < 2; ++p) { unsigned wv[2][2];
#pragma unroll
                                for (int q = 0; q < 2; ++q) { const int rg = 2 * p + q, d0 = dt * 32 + rg * 8; const f32x4 gg = *(const f32x4*)(sg + d0 + 4 * hi);
                                    wv[q][0] = pk2(o[dt][4 * rg] * inv * gg.x, o[dt][4 * rg + 1] * inv * gg.y); wv[q][1] = pk2(o[dt][4 * rg + 2] * inv * gg.z, o[dt][4 * rg + 3] * inv * gg.w); }
                                const auto s0 = __builtin_amdgcn_permlane32_swap(wv[0][0], wv[1][0], false, false); const auto s1 = __builtin_amdgcn_permlane32_swap(wv[0][1], wv[1][1], false, false);
                                u32x4 w; w.x = s0[0]; w.y = s1[0]; w.z = s0[1]; w.w = s1[1];
                                *(u32x4*)(yp + dt * 32 + 16 * p) = w; }
                    }
                }
            }
            }
            NEXT_TICKET(q_ticket);
        }
    }
#undef ATT_ISSUE
    SEAM(5);
    if (IN(6)) REP(6) gemm_ph(std::integral_constant<int, 6>{});
    SEAM(6);
    if (IN(7)) REP(7) {
        PHASE_PTRS
        typedef float f32x16 __attribute__((ext_vector_type(16)));
        const float *g2 = AIN[20], *rw = AIN[21], *rb = AIN[22];
        typedef short bf16x8 __attribute__((ext_vector_type(8)));
        LAS float* part = (LAS float*)lds;
        LAS float* psq = (LAS float*)(lds + 8 * 128 * 33 * 4);
        LAS float* invs = psq + 8 * 128;
        LAS unsigned* lcnt = (LAS unsigned*)(invs + 128);
        const int r32 = lane & 31, hi = lane >> 5;
        const bf16_t* rws = (const bf16_t*)(ws + WS_RWS);
        for (int unit = bid; unit < T / 128; unit += G) {
            const int tb0 = unit * 128;
            __syncthreads();
            if (tid < 32) lcnt[tid] = 0u;
            bf16x8 bw[8][3];
#pragma unroll
            for (int j = 0; j < 8; ++j)
#pragma unroll
                for (int im = 0; im < 3; ++im) bw[j][im] = *(const bf16x8*)(rws + (size_t)(im * NE + r32) * D + 128 * wave + 16 * j + 8 * hi);
            const bf16_t* xp = H1 + (size_t)(tb0 + r32) * D + 128 * wave + 8 * hi;
            bf16x8 xa[2][8];
#pragma unroll
            for (int j = 0; j < 8; ++j) xa[0][j] = *(const bf16x8*)(xp + 16 * j);
#pragma unroll
            for (int g = 0; g < 4; ++g) {
                if (g + 1 < 4) {
#pragma unroll
                    for (int j = 0; j < 8; ++j) xa[(g + 1) & 1][j] = *(const bf16x8*)(xp + (size_t)(32 * (g + 1)) * D + 16 * j); }
                f32x16 acc;
#pragma unroll
                for (int r = 0; r < 16; ++r) acc[r] = 0.f;
                float ssq = 0.f;
#pragma unroll
                for (int j = 0; j < 8; ++j) { const bf16x8 xr = xa[g & 1][j];
                    acc = __builtin_amdgcn_mfma_f32_32x32x16_bf16(xr, bw[j][0], acc, 0, 0, 0);
                    acc = __builtin_amdgcn_mfma_f32_32x32x16_bf16(xr, bw[j][1], acc, 0, 0, 0);
                    acc = __builtin_amdgcn_mfma_f32_32x32x16_bf16(xr, bw[j][2], acc, 0, 0, 0);
                    const u32x4 xw = __builtin_bit_cast(u32x4, xr);
                    const float x0 = bf2f(xw.x & 0xffff), x1 = bf2f(xw.x >> 16), x2 = bf2f(xw.y & 0xffff), x3 = bf2f(xw.y >> 16), x4 = bf2f(xw.z & 0xffff), x5 = bf2f(xw.z >> 16), x6 = bf2f(xw.w & 0xffff), x7 = bf2f(xw.w >> 16);
                    ssq += x0 * x0 + x1 * x1 + x2 * x2 + x3 * x3 + x4 * x4 + x5 * x5 + x6 * x6 + x7 * x7; }
                ssq += __shfl_xor(ssq, 32);
                if (hi == 0) psq[wave * 128 + 32 * g + r32] = ssq;
                LAS float* pg = part + (size_t)(wave * 128 + 32 * g) * 33;
#pragma unroll
                for (int r = 0; r < 16; ++r) pg[((r & 3) + 8 * (r >> 2) + 4 * hi) * 33 + r32] = acc[r];
            }
            __syncthreads();
            for (int idx = tid; idx < 128 * 32; idx += NTHREADS) { const int o = (idx >> 5) * 33 + (idx & 31); float sum = part[o];
#pragma unroll
                for (int w = 1; w < 8; ++w) sum += part[w * 128 * 33 + o];
                part[o] = sum; }
            if (tid < 128) { float q = psq[tid];
#pragma unroll
                for (int w = 1; w < 8; ++w) q += psq[w * 128 + tid];
                invs[tid] = rsqrtf(q * (1.f / D) + 1e-5f); }
            LAS float* lg = part + wave * (32 * 33);
            __syncthreads();
            int sel_e[4] = {0, 0, 0, 0}; unsigned sel_p[4] = {0u, 0u, 0u, 0u}; float sel_g[4] = {0.f, 0.f, 0.f, 0.f};
            const bool picker = (wave < 4) && (lane < 32);
            if (picker) {
                const float inv = invs[wave * 32 + lane];
                float v[32];
#pragma unroll
                for (int e = 0; e < 32; ++e) v[e] = lg[lane * 33 + e] * inv + rb[e];
                unsigned taken = 0u; float tv[4];
#pragma unroll
                for (int k = 0; k < 4; ++k) {
                    float best = -INFINITY; int be = 0;
#pragma unroll
                    for (int e = 0; e < 32; ++e) { const bool ok = !((taken >> e) & 1u) && (v[e] > best); best = ok ? v[e] : best; be = ok ? e : be; }
                    taken |= 1u << be; tv[k] = best; sel_e[k] = be;
                }
                const float e1 = __expf(tv[1] - tv[0]), e2 = __expf(tv[2] - tv[0]), e3 = __expf(tv[3] - tv[0]);
                const float isum = 1.f / (1.f + e1 + e2 + e3);
                sel_g[0] = isum; sel_g[1] = e1 * isum; sel_g[2] = e2 * isum; sel_g[3] = e3 * isum;
#pragma unroll
                for (int k = 0; k < 4; ++k) sel_p[k] = __hip_atomic_fetch_add(&lcnt[sel_e[k]], 1u, __ATOMIC_RELAXED, __HIP_MEMORY_SCOPE_WORKGROUP);
            }
            __syncthreads();
            if (tid < 32) lcnt[32 + tid] = atomicAdd(&cnt[tid], lcnt[tid]);
            __syncthreads();
            if (picker) {
                const int t = tb0 + wave * 32 + lane;
#pragma unroll
                for (int k = 0; k < 4; ++k) { const size_t li = (size_t)sel_e[k] * T + lcnt[32 + sel_e[k]] + sel_p[k];
                    ltok[li] = t; ldst[li] = t * TOPK + k; lgate[li] = sel_g[k]; }
            }
#pragma unroll 4
            for (int i = 0; i < 16; ++i) {
                const int tl = wave * 16 + i; const size_t t = (size_t)tb0 + tl; const float inv = invs[tl];
#pragma unroll
                for (int j = 0; j < 4; ++j) { const u32x2 hw = ((const u32x2*)(H1 + t * D))[lane + 64 * j]; const f32x4 xv = {bf2f(hw.x & 0xffff), bf2f(hw.x >> 16), bf2f(hw.y & 0xffff), bf2f(hw.y >> 16)}; const f32x4 gg = ((const f32x4*)g2)[lane + 64 * j];
                    const f32x4 o = xv * inv * gg; int w8 = __builtin_amdgcn_cvt_pk_fp8_f32(o.x, o.y, 0, false); w8 = __builtin_amdgcn_cvt_pk_fp8_f32(o.z, o.w, w8, true); ((int*)((unsigned char*)XN + t * D))[lane + 64 * j] = w8; }
            }
        }
    }
    SEAM(7);
    if (IN(8)) REP(8) gemm_ph(std::integral_constant<int, 8>{});
    SEAM(8);
    if (IN(9)) REP(9) gemm_ph(std::integral_constant<int, 9>{});
    SEAM(9);
    if (IN(10)) REP(10) {
        PHASE_PTRS
        const float* fg = AIN[27];
        for (int t = gw; t < T; t += NGW) {
            f32x4 v[4]; float ss = 0.f;
#pragma unroll
            for (int j = 0; j < 4; ++j) {
                { const u32x2 hw = ((const u32x2*)(H1 + (size_t)t * D))[lane + 64 * j]; v[j] = (f32x4){bf2f(hw.x & 0xffff), bf2f(hw.x >> 16), bf2f(hw.y & 0xffff), bf2f(hw.y >> 16)}; }
#pragma unroll
                for (int k = 0; k < TOPK; ++k) { const int w = ((const int*)((const unsigned char*)YK + ((size_t)t * TOPK + k) * D))[lane + 64 * j];
                    typedef float f32x2v __attribute__((ext_vector_type(2)));
                    const f32x2v lo2 = __builtin_amdgcn_cvt_pk_f32_fp8(w, false), hi2 = __builtin_amdgcn_cvt_pk_f32_fp8(w, true);
                    v[j].x += lo2.x * 0.0625f; v[j].y += lo2.y * 0.0625f; v[j].z += hi2.x * 0.0625f; v[j].w += hi2.y * 0.0625f; }
                ss += v[j].x * v[j].x + v[j].y * v[j].y + v[j].z * v[j].z + v[j].w * v[j].w;
            }
            ss = wave_sum(ss);
            const float inv = rsqrtf(ss * (1.f / D) + 1e-5f);
#pragma unroll
            for (int j = 0; j < 4; ++j) { const f32x4 gg = ((const f32x4*)fg)[lane + 64 * j]; ((f32x4*)(OUT + (size_t)t * D))[lane + 64 * j] = v[j] * inv * gg; }
        }
    }
#undef IN
}

constexpr int NPHASES = 11;
extern "C" void kernel_launch(void* const* d_in, const int* in_sizes, int n_in, void* d_out, int out_size, void* d_ws, size_t ws_size, hipStream_t stream) {
    static int grid = 0;
    if (grid == 0) {
        if (n_in != 28 || out_size != T * D || ws_size < WS_END) { fprintf(stderr, "kernel_launch: unexpected shapes (n_in %d out %d ws %zu)\n", n_in, out_size, ws_size); grid = -1; return; }
        if (hipFuncSetAttribute((const void*)mk_fwd, hipFuncAttributeMaxDynamicSharedMemorySize, LDS_BYTES) != hipSuccess) { fprintf(stderr, "kernel_launch: hipFuncSetAttribute failed\n"); grid = -1; return; }
        int dev = 0, cus = 0;
        if (hipGetDevice(&dev) != hipSuccess || hipDeviceGetAttribute(&cus, hipDeviceAttributeMultiprocessorCount, dev) != hipSuccess) { grid = -1; return; }
        grid = cus;
    }
    if (grid < 0) return;
    (void)hipMemsetAsync((char*)d_ws + WS_CTL, 0, CTL_BYTES, stream);
    Args a{};
    for (int i = 0; i < 28; ++i) a.in[i] = (const float*)d_in[i];
    a.out = (float*)d_out; a.ws = (unsigned char*)d_ws;
#ifndef N_LAUNCH
#define N_LAUNCH 1
#endif
    if (N_LAUNCH == 1) { a.ph_lo = 0; a.ph_hi = NPHASES; hipLaunchKernelGGL(mk_fwd, dim3(grid), dim3(NTHREADS), LDS_BYTES, stream, a); }
    else for (int p = 0; p < NPHASES; ++p) {
        a.ph_lo = p; a.ph_hi = p + 1;
        hipLaunchKernelGGL(mk_fwd, dim3(grid), dim3(NTHREADS), LDS_BYTES, stream, a);
    }
}
```
